# Optimizing an MI355X kernel written in HIP

```python
import functools
import jax, jax.numpy as jnp
from jax import lax
import numpy as np

D_MODEL = 1024
BATCH = 16
SEQ = 2048
DEPTH = 1
DEC_BATCH = 8
DEC_SEQ = 16
PAST_LEN = 1024

CHUNK = 64
HEAD_DIM = 64
N_HEADS_A = 8
N_HEADS_B = 8
WIDTH_A = N_HEADS_A * HEAD_DIM
WIDTH_B = N_HEADS_B * HEAD_DIM
MIX_WIDTH = WIDTH_A + WIDTH_B
Q_BLOCK = 128
LEFT_CHUNKS = 8
LEFT_REACH = LEFT_CHUNKS * CHUNK
BAND = LEFT_REACH + CHUNK
REL_CLIP = 128
D_FF = -(-(8 * D_MODEL) // (3 * 256)) * 256
D_IN = 3 * WIDTH_A + N_HEADS_A + 3 * WIDTH_B
EPS = 1e-6
SCALE = HEAD_DIM ** -0.5

kernel_name = "hymba_fox_chunkband_stream_encoder"


def rmsnorm(x, g):
    xf = x.astype(jnp.float32)
    y = xf * lax.rsqrt(jnp.mean(xf * xf, axis=-1, keepdims=True) + EPS)
    return (y * g.astype(jnp.float32)).astype(x.dtype)


def project_in(h, w_in, b_forget):
    z = h @ w_in
    splits = [WIDTH_A, 2 * WIDTH_A, 3 * WIDTH_A, 3 * WIDTH_A + N_HEADS_A,
              3 * WIDTH_A + N_HEADS_A + WIDTH_B, 3 * WIDTH_A + N_HEADS_A + 2 * WIDTH_B]
    qa, ka, va, fa, qb, kb, vb = jnp.split(z, splits, axis=-1)
    heads = lambda t, n: t.reshape(t.shape[:-1] + (n, HEAD_DIM))
    logf = jax.nn.log_sigmoid((fa + b_forget).astype(jnp.float32))
    return (heads(qa, N_HEADS_A), heads(ka, N_HEADS_A), heads(va, N_HEADS_A), logf,
            heads(qb, N_HEADS_B), heads(kb, N_HEADS_B), heads(vb, N_HEADS_B))


def attend(q, k, v, bias, valid):
    s = jnp.einsum('bqhd,bkhd->bhqk', q, k).astype(jnp.float32) * SCALE + bias
    s = jnp.where(valid, s, -jnp.inf)
    p = jax.nn.softmax(s, axis=-1)
    return jnp.einsum('bhqk,bkhd->bqhd', p.astype(v.dtype), v)


def rel_bias_matrix(rel_bias, dist):
    idx = jnp.clip(dist, -REL_CLIP, REL_CLIP) + REL_CLIP
    return rel_bias[:, idx].astype(jnp.float32)


def fox_prompt(q, k, v, logf):
    b, s = q.shape[0], q.shape[1]
    nb = s // Q_BLOCK
    c = jnp.cumsum(logf, axis=1).transpose(0, 2, 1)
    q_blocks = q.reshape(b, nb, Q_BLOCK, N_HEADS_A, HEAD_DIM).transpose(1, 0, 2, 3, 4)
    c_blocks = c.reshape(b, N_HEADS_A, nb, Q_BLOCK).transpose(2, 0, 1, 3)
    spos = jnp.arange(s)

    def one_block(args):
        qb_, cq, blk = args
        tpos = blk * Q_BLOCK + jnp.arange(Q_BLOCK)
        bias = cq[..., :, None] - c[..., None, :]
        valid = spos[None, :] <= tpos[:, None]
        return attend(qb_, k, v, bias, valid)

    out = lax.map(one_block, (q_blocks, c_blocks, jnp.arange(nb)))
    return out.transpose(1, 0, 2, 3, 4).reshape(b, s, N_HEADS_A, HEAD_DIM)


def fox_sample(q, k, v, logf, cache_k, cache_v, cache_logf):
    p_len, t_len = cache_k.shape[1], q.shape[1]
    k_all = jnp.concatenate([cache_k, k], axis=1)
    v_all = jnp.concatenate([cache_v, v], axis=1)
    c = jnp.cumsum(jnp.concatenate([cache_logf.astype(jnp.float32), logf], axis=1), axis=1)
    c = c.transpose(0, 2, 1)
    bias = c[..., p_len:, None] - c[..., None, :]
    valid = jnp.arange(p_len + t_len)[None, :] <= (p_len + jnp.arange(t_len))[:, None]
    return attend(q, k_all, v_all, bias, valid)


def band_prompt(q, k, v, rel_bias):
    b, s = q.shape[0], q.shape[1]
    nc = s // CHUNK
    pad = ((0, 0), (LEFT_REACH, 0), (0, 0), (0, 0))
    kp, vp = jnp.pad(k, pad), jnp.pad(v, pad)
    i = jnp.arange(CHUNK)
    j = jnp.arange(BAND)
    bias = rel_bias_matrix(rel_bias, i[:, None] + LEFT_REACH - j[None, :])

    def one_chunk(ci):
        start = ci * CHUNK
        qc = lax.dynamic_slice_in_dim(q, start, CHUNK, axis=1)
        kband = lax.dynamic_slice_in_dim(kp, start, BAND, axis=1)
        vband = lax.dynamic_slice_in_dim(vp, start, BAND, axis=1)
        valid = (start + j - LEFT_REACH) >= 0
        return attend(qc, kband, vband, bias, valid[None, :])

    out = lax.map(one_chunk, jnp.arange(nc))
    return out.transpose(1, 0, 2, 3, 4).reshape(b, s, N_HEADS_B, HEAD_DIM)


def band_sample(q, k, v, rel_bias, cache_k, cache_v):
    l_len, t_len = cache_k.shape[1], q.shape[1]
    k_all = jnp.concatenate([cache_k, k], axis=1)
    v_all = jnp.concatenate([cache_v, v], axis=1)
    dist = jnp.arange(t_len)[:, None] + l_len - jnp.arange(l_len + t_len)[None, :]
    bias = rel_bias_matrix(rel_bias, dist)
    return attend(q, k_all, v_all, bias, True)


def trunk_layer(x, fox_fn, band_fn, norm_mix_pre, w_in, b_forget, gain_out_a, gain_out_b,
                w_out, norm_mix_post, norm_ffn_pre, w_gate, w_up, w_down, norm_ffn_post):
    h = rmsnorm(x, norm_mix_pre)
    qa, ka, va, logf, qb, kb, vb = project_in(h, w_in, b_forget)
    oa = fox_fn(qa, ka, va, logf)
    ob = band_fn(qb, kb, vb)
    oa = rmsnorm(oa.reshape(oa.shape[:-2] + (WIDTH_A,)), gain_out_a)
    ob = rmsnorm(ob.reshape(ob.shape[:-2] + (WIDTH_B,)), gain_out_b)
    mix = jnp.concatenate([oa, ob], axis=-1) @ w_out
    x = x + rmsnorm(mix, norm_mix_post)
    hf = rmsnorm(x, norm_ffn_pre)
    ff = (jax.nn.silu(hf @ w_gate) * (hf @ w_up)) @ w_down
    x = x + rmsnorm(ff, norm_ffn_post)
    return x, (ka, va, logf, kb, vb)


def setup_inputs(seed: int = 0) -> dict:
    key = jax.random.key(seed)
    ks = jax.random.split(key, 20)
    nrm = jax.random.normal
    f32 = jnp.float32
    b_len = min(LEFT_REACH, PAST_LEN)
    gain = lambda k, n: 1.0 + 0.05 * nrm(k, (DEPTH, n), f32)
    return {
        "x_prompt": nrm(ks[0], (BATCH, SEQ, D_MODEL), f32),
        "x_sample": nrm(ks[1], (DEC_BATCH, DEC_SEQ, D_MODEL), f32),
        "cache_a_k": nrm(ks[2], (DEPTH, DEC_BATCH, PAST_LEN, N_HEADS_A, HEAD_DIM), f32),
        "cache_a_v": nrm(ks[3], (DEPTH, DEC_BATCH, PAST_LEN, N_HEADS_A, HEAD_DIM), f32),
        "cache_a_logf": jax.nn.log_sigmoid(4.0 + nrm(ks[4], (DEPTH, DEC_BATCH, PAST_LEN, N_HEADS_A), f32)),
        "cache_b_k": nrm(ks[5], (DEPTH, DEC_BATCH, b_len, N_HEADS_B, HEAD_DIM), f32),
        "cache_b_v": nrm(ks[6], (DEPTH, DEC_BATCH, b_len, N_HEADS_B, HEAD_DIM), f32),
        "norm_mix_pre": gain(ks[7], D_MODEL),
        "w_in": nrm(ks[8], (DEPTH, D_MODEL, D_IN), f32) * D_MODEL ** -0.5,
        "b_forget": 4.0 + 0.5 * nrm(ks[9], (DEPTH, N_HEADS_A), f32),
        "rel_bias": 0.1 * nrm(ks[10], (DEPTH, N_HEADS_B, 2 * REL_CLIP + 1), f32),
        "gain_out_a": gain(ks[11], WIDTH_A),
        "gain_out_b": gain(ks[12], WIDTH_B),
        "w_out": nrm(ks[13], (DEPTH, MIX_WIDTH, D_MODEL), f32) * MIX_WIDTH ** -0.5,
        "norm_mix_post": gain(ks[14], D_MODEL),
        "norm_ffn_pre": gain(ks[15], D_MODEL),
        "w_gate": nrm(ks[16], (DEPTH, D_MODEL, D_FF), f32) * D_MODEL ** -0.5,
        "w_up": nrm(ks[17], (DEPTH, D_MODEL, D_FF), f32) * D_MODEL ** -0.5,
        "w_down": nrm(ks[18], (DEPTH, D_FF, D_MODEL), f32) * D_FF ** -0.5,
        "norm_ffn_post": gain(ks[19], D_MODEL),
    }


def reference(x_prompt, x_sample, cache_a_k, cache_a_v, cache_a_logf, cache_b_k, cache_b_v,
              norm_mix_pre, w_in, b_forget, rel_bias, gain_out_a, gain_out_b, w_out,
              norm_mix_post, norm_ffn_pre, w_gate, w_up, w_down, norm_ffn_post):
    xp, xs = x_prompt, x_sample
    keep = min(LEFT_REACH, x_prompt.shape[1])
    pa_k, pa_v, pa_f, pb_k, pb_v = [], [], [], [], []
    sa_k, sa_v, sa_f, sb_k, sb_v = [], [], [], [], []
    for l in range(DEPTH):
        weights = (norm_mix_pre[l], w_in[l], b_forget[l], gain_out_a[l], gain_out_b[l], w_out[l],
                   norm_mix_post[l], norm_ffn_pre[l], w_gate[l], w_up[l], w_down[l], norm_ffn_post[l])
        xp, (ka, va, lf, kb, vb) = trunk_layer(
            xp, fox_prompt, functools.partial(band_prompt, rel_bias=rel_bias[l]), *weights)
        pa_k.append(ka); pa_v.append(va); pa_f.append(lf)
        pb_k.append(kb[:, kb.shape[1] - keep:]); pb_v.append(vb[:, vb.shape[1] - keep:])
        xs, (ka, va, lf, kb, vb) = trunk_layer(
            xs,
            functools.partial(fox_sample, cache_k=cache_a_k[l], cache_v=cache_a_v[l], cache_logf=cache_a_logf[l]),
            functools.partial(band_sample, rel_bias=rel_bias[l], cache_k=cache_b_k[l], cache_v=cache_b_v[l]),
            *weights)
        sa_k.append(ka); sa_v.append(va); sa_f.append(lf); sb_k.append(kb); sb_v.append(vb)
    st = jnp.stack
    return (xp, xs, st(pa_k), st(pa_v), st(pa_f), st(pb_k), st(pb_v),
            st(sa_k), st(sa_v), st(sa_f), st(sb_k), st(sb_v))
```

```cpp
#include <hip/hip_runtime.h>
#include <hip/hip_cooperative_groups.h>
#include <hip/hip_bf16.h>
#include <cstdio>
#include <cstdint>
#include <cmath>
namespace cg = cooperative_groups;

constexpr int DMODEL = 1024, NB = 16, SEQ = 2048, MP = NB * SEQ  , SBATCH = 8, STOK = 16, MS = SBATCH * STOK  ;
constexpr int MTOT = MP + MS  , MPAD = 33024  , PAST = 1024, BLEN = 512;
constexpr int DFF = 2816, DIN = 3080, NQKV = 3072, NGU = 2 * DFF;
constexpr float EPS = 1e-6f, LOG2E = 1.4426950408889634f;
constexpr float C2 = 0.125f * 1.4426950408889634f;
constexpr size_t O_Y = 0, O_AKP = 33685504, O_AVP = 50462720, O_LFP = 67239936, O_BKP = 67502080, O_BVP = 71696384,
                 O_AKS = 75890688, O_AVS = 75956224, O_LFS = 76021760, O_BKS = 76022784, O_BVS = 76088320, O_END = 76153856;
namespace pg8 {
#define PG8_LAS __attribute__((address_space(3)))
typedef unsigned short bf16_t;
typedef short bf16x8 __attribute__((ext_vector_type(8)));
typedef float f32x4 __attribute__((ext_vector_type(4)));
typedef unsigned u32x4 __attribute__((ext_vector_type(4)));
constexpr int BM = 256, BK = 64, HALF = 128, HTB = HALF * BK * 2  , STAGE_BYTES = 8 * HTB, NXCD = 8, WGM = 8;

__host__ __device__ __forceinline__ int lds_byte(int r, int c) { const int st = (r >> 4) * 2 + (c >> 5), rr = r & 15, cc = c & 31, ob = rr * 64 + cc * 2; return st * 1024 + (ob ^ (((ob >> 9) & 1) << 5)); }
__host__ __device__ __forceinline__ void stage_rc(int b, int& R, int& C) { const int st = b / 1024, sb = b % 1024, swz = sb ^ (((sb >> 9) & 1) << 5); R = (st >> 1) * 16 + swz / 64; C = (st & 1) * 32 + (swz % 64) / 2; }
__host__ __device__ __forceinline__ int perm32(int rho) { const int n = rho >> 4, i = rho & 15; return 8 * (i >> 2) + 4 * n + (i & 3); }

struct Unit { int pm, pn; };
struct Gemm { const bf16_t* A; const bf16_t* Bt; int M, N, K; };

struct StaticOrder {
    int nM, nN, nwg, G, c;
    __host__ __device__ void init(int M, int N, int G_, int c_) { nM = M / BM; nN = N / BM; nwg = nM * nN; G = G_; c = c_; }
    __host__ __device__ bool next(int i, Unit& u) const {
        const long L = (long)i * G + c; if (L >= nwg) return false;
        int wgid = (int)L; { const int q = nwg / NXCD, r = nwg % NXCD, xcd = wgid % NXCD, off = wgid / NXCD; wgid = (xcd < r ? xcd * (q + 1) : r * (q + 1) + (xcd - r) * q) + off; }
        const int nig = WGM * nN, gid = wgid / nig, fm = gid * WGM, gsz = (nM - fm) < WGM ? (nM - fm) : WGM;
        u.pm = fm + ((wgid % nig) % gsz); u.pn = (wgid % nig) / gsz; return true;
    }
    __device__ __forceinline__ void a_ready(const Unit&) const {}
    __device__ __forceinline__ void done(const Unit&) const {}
};

__device__ __forceinline__ unsigned cvt_pk_bf16(float lo, float hi) { unsigned r; asm volatile("v_cvt_pk_bf16_f32 %0, %1, %2" : "=v"(r) : "v"(lo), "v"(hi)); return r; }
struct OneUnit {
    Unit u;
    __device__ __forceinline__ bool next(int i, Unit& o) const { if (i) return false; o = u; return true; }
    __device__ __forceinline__ void a_ready(const Unit&) const {}
    __device__ __forceinline__ void done(const Unit&) const {}
};
typedef float f32x2 __attribute__((ext_vector_type(2)));
struct EpiQKV {
    static constexpr bool PERM = true, AFTER_DRAIN = false, HAS_MID = false; static constexpr int MID_T = -1;
    bf16_t* QKV; float* out;
    __device__ __forceinline__ void mid(f32x4 (&)[2][2][4][2], int, int) const {}
    __device__ __forceinline__ void operator()(const f32x4 (&acc)[2][2][4][2], const Unit& u, int wr, int wc, int fr, int fq) const {
        const int type = u.pn >> 1, colt = (u.pn & 1) * 256 + wc * 32 + 8 * fq;
        const float sc = (type == 0 || type == 3) ? C2 : 1.f;
        const bool sample = (u.pm == MP / 256);
        float* fb = nullptr;
        if (type == 1 || type == 2 || type == 4 || type == 5) {
            if (sample) fb = out + (type == 1 ? O_AKS : type == 2 ? O_AVS : type == 4 ? O_BKS : O_BVS);
            else if (type < 3) fb = out + (type == 1 ? O_AKP : O_AVP) + (size_t)u.pm * 256 * 512;
            else { const int bt = u.pm & 7; if (bt >= 6) fb = out + (type == 4 ? O_BKP : O_BVP) + ((size_t)(u.pm >> 3) * 512 + (size_t)(bt - 6) * 256) * 512; }
        }
#pragma unroll
        for (int ai = 0; ai < 2; ++ai) {
            if (sample && ai == 1) break;
#pragma unroll
            for (int m = 0; m < 4; ++m) { const int rl = ai * HALF + wr * 64 + m * 16 + fr;
                bf16_t* rowp = QKV + (size_t)(u.pm * BM + rl) * NQKV + u.pn * BM + wc * 32 + 8 * fq;
#pragma unroll
                for (int bj = 0; bj < 2; ++bj) { f32x4 v0 = acc[ai][bj][m][0], v1 = acc[ai][bj][m][1];
                    if (fb) { float* fp = fb + (size_t)rl * 512 + colt + bj * HALF; *(f32x4*)fp = v0; *(f32x4*)(fp + 4) = v1; }
                    v0 = v0 * sc; v1 = v1 * sc; u32x4 w; w.x = cvt_pk_bf16(v0[0], v0[1]); w.y = cvt_pk_bf16(v0[2], v0[3]); w.z = cvt_pk_bf16(v1[0], v1[1]); w.w = cvt_pk_bf16(v1[2], v1[3]);
                    *(u32x4*)(rowp + bj * HALF) = w; } }
        }
    }
};
struct EpiSwiGLU {
    static constexpr bool PERM = true, AFTER_DRAIN = false, HAS_MID = false; static constexpr int MID_T = -1;
    bf16_t* H;
    __device__ __forceinline__ void mid(f32x4 (&)[2][2][4][2], int, int) const {}
    __device__ __forceinline__ void operator()(const f32x4 (&acc)[2][2][4][2], const Unit& u, int wr, int wc, int fr, int fq) const {
#pragma unroll
        for (int ai = 0; ai < 2; ++ai)
#pragma unroll
            for (int m = 0; m < 4; ++m) { const int row = u.pm * BM + ai * HALF + wr * 64 + m * 16 + fr;
                float hv[8];
#pragma unroll
                for (int n = 0; n < 2; ++n)
#pragma unroll
                    for (int e = 0; e < 4; ++e) { const float g = acc[ai][0][m][n][e], up = acc[ai][1][m][n][e];
                        hv[4 * n + e] = g * up * __builtin_amdgcn_rcpf(1.0f + __builtin_amdgcn_exp2f(-g * LOG2E)); }
                u32x4 w; w.x = cvt_pk_bf16(hv[0], hv[1]); w.y = cvt_pk_bf16(hv[2], hv[3]); w.z = cvt_pk_bf16(hv[4], hv[5]); w.w = cvt_pk_bf16(hv[6], hv[7]);
                *(u32x4*)(H + (size_t)row * DFF + u.pn * HALF + wc * 32 + 8 * fq) = w; }
    }
};
template <bool MID> struct EpiF32 {
    static constexpr bool PERM = false, AFTER_DRAIN = false, HAS_MID = MID; static constexpr int MID_T = 8;
    float* F; int ldc; const PG8_LAS float* tab;
    __device__ __forceinline__ void mid(f32x4 (&acc)[2][2][4][2], int wr, int fr) const {
#pragma unroll
        for (int ai = 0; ai < 2; ++ai)
#pragma unroll
            for (int m = 0; m < 4; ++m) { const float s = tab[(ai * HALF + wr * 64 + m * 16 + fr) * 2];
#pragma unroll
                for (int bj = 0; bj < 2; ++bj)
#pragma unroll
                    for (int n = 0; n < 2; ++n) acc[ai][bj][m][n] = acc[ai][bj][m][n] * s; }
    }
    __device__ __forceinline__ void operator()(const f32x4 (&acc)[2][2][4][2], const Unit& u, int wr, int wc, int fr, int fq) const {
        const int col0 = u.pn * BM + wc * 32 + 4 * fq;
#pragma unroll
        for (int ai = 0; ai < 2; ++ai)
#pragma unroll
            for (int m = 0; m < 4; ++m) { const int rl = ai * HALF + wr * 64 + m * 16 + fr; const float s = MID ? tab[rl * 2 + 1] : 1.f;
                float* rowp = F + (size_t)(u.pm * BM + rl) * ldc + col0;
#pragma unroll
                for (int bj = 0; bj < 2; ++bj)
#pragma unroll
                    for (int n = 0; n < 2; ++n) *(f32x4*)(rowp + bj * HALF + n * 16) = acc[ai][bj][m][n] * s; }
    }
};

template <class Epi, class Sched, bool ALIGN_EPI = false, bool SP2 = false>
__device__ __forceinline__ void gemm_phase(PG8_LAS unsigned char* lds, const Gemm g, const Sched& S, const Epi& E) {
    int tid_ = threadIdx.x; asm volatile("" : "+v"(tid_));
    const int tid = tid_, wid = __builtin_amdgcn_readfirstlane(tid >> 6), lane = tid & 63, wr = wid >> 2, wc = wid & 3, fr = lane & 15, fq = lane >> 4;
    const int K = g.K, nt = K / BK;
    unsigned voffA[2], voffB[2];
#pragma unroll
    for (int i = 0; i < 2; ++i) { int R, C; stage_rc(tid * 16 + i * 8192, R, C); const int Rb = Epi::PERM ? ((R & ~31) + perm32(R & 31)) : R;
        voffA[i] = (unsigned)(R * K + C) * 2u; voffB[i] = (unsigned)(Rb * K + C) * 2u; }
    const size_t kstep = (size_t)(BK * 2);
    const size_t hstep = (size_t)HALF * K * 2;
    const size_t tstep = 2 * hstep;
    const unsigned ldsw = (unsigned)wid * 1024u;
    const int aoff = lds_byte(wr * 64 + fr, fq * 8), boff = lds_byte(wc * 32 + fr, fq * 8);
#define PG8_SA(b, h) (((b) * 2 + (h)) * HTB)
#define PG8_SB(b, h) ((4 + (b) * 2 + (h)) * HTB)
#define PG8_STAGE(bufoff, gbase, voff) do { _Pragma("unroll") for (int _i = 0; _i < 2; ++_i) \
        __builtin_amdgcn_global_load_lds((const unsigned*)((const char*)(gbase) + (voff)[_i]), (PG8_LAS unsigned*)(lds + (bufoff) + ldsw + _i * 8192), 16, 0, 0); } while (0)
#define PG8_LDA(dst, b, h) do { _Pragma("unroll") for (int m = 0; m < 4; ++m) _Pragma("unroll") for (int k = 0; k < 2; ++k) dst[m][k] = *(const PG8_LAS bf16x8*)(lds + PG8_SA(b, h) + aoff + m * 2048 + k * 1024); } while (0)
#define PG8_LDB(dst, b, h) do { _Pragma("unroll") for (int n = 0; n < 2; ++n) _Pragma("unroll") for (int k = 0; k < 2; ++k) dst[n][k] = *(const PG8_LAS bf16x8*)(lds + PG8_SB(b, h) + boff + n * 2048 + k * 1024); } while (0)
#define PG8_MMA(ai, bj, At, Bt) do { __builtin_amdgcn_s_setprio(1); _Pragma("unroll") for (int m = 0; m < 4; ++m) _Pragma("unroll") for (int n = 0; n < 2; ++n) _Pragma("unroll") for (int k = 0; k < 2; ++k) \
        acc[ai][bj][m][n] = __builtin_amdgcn_mfma_f32_16x16x32_bf16(Bt[n][k], At[m][k], acc[ai][bj][m][n], 0, 0, 0); __builtin_amdgcn_s_setprio(0); } while (0)
#define PG8_WAIT_V(n) asm volatile("s_waitcnt vmcnt(" #n ")" ::: "memory")
#define PG8_WAIT_L(n) asm volatile("s_waitcnt lgkmcnt(" #n ")" ::: "memory")
#define PG8_BAR __builtin_amdgcn_s_barrier()
#define PG8_SCHED __builtin_amdgcn_sched_barrier(0)
    Unit cur, nxt; int ui = 0;
    if (!S.next(0, cur)) return;
    f32x4 acc[2][2][4][2];
#pragma unroll
    for (int a = 0; a < 2; ++a)
#pragma unroll
        for (int b = 0; b < 2; ++b)
#pragma unroll
            for (int m = 0; m < 4; ++m)
#pragma unroll
                for (int n = 0; n < 2; ++n) acc[a][b][m][n] = (f32x4){0.f, 0.f, 0.f, 0.f};
    bf16x8 At[4][2], B0[2][2], B1[2][2];
    const char* cA = (const char*)g.A + (size_t)cur.pm * tstep; const char* cB = (const char*)g.Bt + (size_t)cur.pn * tstep;
    S.a_ready(cur);
    if constexpr (SP2) {
        PG8_STAGE(PG8_SB(0, 0), cB, voffB); PG8_STAGE(PG8_SB(0, 1), cB + hstep, voffB); PG8_STAGE(PG8_SA(0, 0), cA, voffA); PG8_STAGE(PG8_SA(0, 1), cA + hstep, voffA);
        if (wr == 1) PG8_BAR;
        PG8_WAIT_V(2); PG8_BAR;
        PG8_STAGE(PG8_SB(1, 0), cB + kstep, voffB); PG8_STAGE(PG8_SA(1, 0), cA + kstep, voffA); PG8_STAGE(PG8_SB(1, 1), cB + hstep + kstep, voffB);
        PG8_WAIT_V(6); PG8_BAR;
    } else {
        PG8_STAGE(PG8_SB(0, 0), cB, voffB); PG8_STAGE(PG8_SA(0, 0), cA, voffA); PG8_STAGE(PG8_SB(0, 1), cB + hstep, voffB); PG8_STAGE(PG8_SA(0, 1), cA + hstep, voffA);
        if (wr == 1) PG8_BAR;
        PG8_WAIT_V(4); PG8_BAR;
        PG8_STAGE(PG8_SB(1, 0), cB + kstep, voffB); PG8_STAGE(PG8_SA(1, 0), cA + kstep, voffA); PG8_STAGE(PG8_SB(1, 1), cB + hstep + kstep, voffB);
        PG8_WAIT_V(6); PG8_BAR;
    }
    for (;;) {
        const bool has_next = S.next(ui + 1, nxt);
        const char* nA = has_next ? (const char*)g.A + (size_t)nxt.pm * tstep : cA; const char* nB = has_next ? (const char*)g.Bt + (size_t)nxt.pn * tstep : cB;
        for (int t = 0; t < nt; t += 2) {
            const bool last = (t == nt - 2);
            if constexpr (Epi::HAS_MID) { if (t == Epi::MID_T) E.mid(acc, wr, fr); }
            const char* a1 = cA + (size_t)(t + 1) * kstep;
            const char* a2 = last ? nA : cA + (size_t)(t + 2) * kstep; const char* b2 = last ? nB : cB + (size_t)(t + 2) * kstep;
            const char* a3 = a2 + kstep; const char* b3 = b2 + kstep;
            if (last && has_next) S.a_ready(nxt);
            if constexpr (SP2) {
            PG8_LDB(B0, 0, 0); PG8_LDB(B1, 0, 1); PG8_SCHED; PG8_LDA(At, 0, 0); PG8_STAGE(PG8_SA(1, 1), a1 + hstep, voffA);
            PG8_WAIT_V(8); PG8_WAIT_L(0); PG8_BAR; PG8_MMA(0, 0, At, B0); PG8_MMA(0, 1, At, B1); PG8_BAR; PG8_SCHED;
            PG8_LDA(At, 0, 1); PG8_STAGE(PG8_SB(0, 0), b2, voffB); PG8_STAGE(PG8_SB(0, 1), b2 + hstep, voffB); PG8_STAGE(PG8_SA(0, 0), a2, voffA);
            PG8_WAIT_V(8); PG8_WAIT_L(0); PG8_BAR; PG8_MMA(1, 0, At, B0); PG8_MMA(1, 1, At, B1); PG8_BAR; PG8_SCHED;
            PG8_LDB(B0, 1, 0); PG8_LDB(B1, 1, 1); PG8_SCHED; PG8_LDA(At, 1, 0); PG8_STAGE(PG8_SA(0, 1), a2 + hstep, voffA);
            PG8_WAIT_V(8); PG8_WAIT_L(0); PG8_BAR; PG8_MMA(0, 0, At, B0); PG8_MMA(0, 1, At, B1); PG8_BAR; PG8_SCHED;
            PG8_LDA(At, 1, 1); PG8_STAGE(PG8_SB(1, 0), b3, voffB); PG8_STAGE(PG8_SB(1, 1), b3 + hstep, voffB); PG8_STAGE(PG8_SA(1, 0), a3, voffA);
            PG8_WAIT_V(8); PG8_WAIT_L(0); PG8_BAR; PG8_MMA(1, 0, At, B0); PG8_MMA(1, 1, At, B1); PG8_BAR; PG8_SCHED;
            } else {
            PG8_LDB(B0, 0, 0); PG8_SCHED; PG8_LDA(At, 0, 0); PG8_STAGE(PG8_SA(1, 1), a1 + hstep, voffA);
            PG8_WAIT_L(8); PG8_BAR; PG8_WAIT_L(0); PG8_MMA(0, 0, At, B0); PG8_BAR; PG8_SCHED;
            PG8_LDB(B1, 0, 1); PG8_STAGE(PG8_SB(0, 0), b2, voffB);
            PG8_BAR; PG8_WAIT_L(0); PG8_MMA(0, 1, At, B1); PG8_BAR;
            PG8_LDA(At, 0, 1); PG8_STAGE(PG8_SA(0, 0), a2, voffA);
            PG8_BAR; PG8_WAIT_L(0); PG8_MMA(1, 0, At, B0); PG8_BAR; PG8_SCHED;
            PG8_STAGE(PG8_SB(0, 1), b2 + hstep, voffB);
            PG8_WAIT_V(6); PG8_BAR; PG8_MMA(1, 1, At, B1); PG8_BAR;
            PG8_LDB(B0, 1, 0); PG8_SCHED; PG8_LDA(At, 1, 0); PG8_STAGE(PG8_SA(0, 1), a2 + hstep, voffA);
            PG8_WAIT_L(8); PG8_BAR; PG8_WAIT_L(0); PG8_MMA(0, 0, At, B0); PG8_BAR; PG8_SCHED;
            PG8_LDB(B1, 1, 1); PG8_STAGE(PG8_SB(1, 0), b3, voffB);
            PG8_BAR; PG8_WAIT_L(0); PG8_MMA(0, 1, At, B1); PG8_BAR;
            PG8_LDA(At, 1, 1); PG8_STAGE(PG8_SA(1, 0), a3, voffA);
            PG8_BAR; PG8_WAIT_L(0); PG8_MMA(1, 0, At, B0); PG8_BAR; PG8_SCHED;
            PG8_STAGE(PG8_SB(1, 1), b3 + hstep, voffB);
            PG8_WAIT_V(6); PG8_BAR; PG8_MMA(1, 1, At, B1); PG8_BAR;
            }
        }
        if constexpr (ALIGN_EPI) { if (wr == 0) PG8_BAR; }
        if constexpr (!Epi::AFTER_DRAIN) { E(acc, cur, wr, wc, fr, fq); S.done(cur); }
        if (!has_next) break;
#pragma unroll
        for (int a = 0; a < 2; ++a)
#pragma unroll
            for (int b = 0; b < 2; ++b)
#pragma unroll
                for (int m = 0; m < 4; ++m)
#pragma unroll
                    for (int n = 0; n < 2; ++n) acc[a][b][m][n] = (f32x4){0.f, 0.f, 0.f, 0.f};
        cur = nxt; cA = nA; cB = nB; ++ui;
        if constexpr (ALIGN_EPI) { if (wr == 1) PG8_BAR; }
    }
    PG8_WAIT_V(0);
    if constexpr (!ALIGN_EPI) { if (wr == 0) PG8_BAR; }
    PG8_BAR;
    if constexpr (Epi::AFTER_DRAIN) { E.fused(acc, cur, wr, wc, fr, fq, lds, wid, lane); S.done(cur); }
#undef PG8_SA
#undef PG8_SB
#undef PG8_STAGE
#undef PG8_LDA
#undef PG8_LDB
#undef PG8_MMA
#undef PG8_WAIT_V
#undef PG8_WAIT_L
#undef PG8_BAR
#undef PG8_SCHED
}
}
#include <hip/hip_bf16.h>
#include <cmath>
#ifndef NOPOST
#define NOPOST 0
#endif
#ifndef NOSSQ
#define NOSSQ 0
#endif
namespace attn_body {
using bf16=__hip_bfloat16;
using bf16x8=__attribute__((ext_vector_type(8)))short;
using s16x4=__attribute__((ext_vector_type(4)))short;
using f32x16=__attribute__((ext_vector_type(16)))float;
using u32x4=__attribute__((ext_vector_type(4)))unsigned;
constexpr int SEQ=2048,D=64,DM=3072,DMO=1024;
constexpr int NW=8,QBLK=32,QB=QBLK*NW,KVBLK=64,NQB=SEQ/QB;
constexpr int ATTN_PITCH=DM, ATTN_UNIT_ROWS=QB;
__device__ __forceinline__ int crow(int r,int hi){return (r&3)+8*(r>>2)+4*hi;}
#define SBAR() __builtin_amdgcn_sched_barrier(0)
__device__ __forceinline__ void cmask(f32x16&p0,f32x16&p1,int jb,int qrel,int hi){
  const float NEG=-INFINITY; int kb=64*jb+4*hi;
  #pragma unroll
  for(int r=0;r<16;++r){int kv=kb+(r&3)+8*(r>>2); if(kv>qrel)p0[r]=NEG; if(kv+32>qrel)p1[r]=NEG;}
}

constexpr int NSLOT=3, SLOTB=8192;
constexpr int LDS_K=0, LDS_V=NSLOT*SLOTB, LDS_WS=2*NSLOT*SLOTB, LDS_OST=LDS_WS+NW*64*4, LDS_BYTES=LDS_OST+NW*4096, LDS_CB=LDS_BYTES, LDS_TOTAL=LDS_CB+8192;
constexpr float C2=0.125f*1.4426950408889634f;
__device__ __forceinline__ void glds16(const void*gsrc,unsigned lds_dst){unsigned keep;
  asm volatile("s_mov_b32 %0, m0\n\ts_mov_b32 m0, %2\n\ts_nop 0\n\tglobal_load_lds_dwordx4 %1, off\n\ts_mov_b32 m0, %0":"=&s"(keep):"v"(gsrc),"s"(lds_dst):"memory");}
__device__ __forceinline__ float max3f(float a,float b,float c){float r;asm("v_max3_f32 %0, %1, %2, %3":"=v"(r):"v"(a),"v"(b),"v"(c));return r;}
__device__ __forceinline__ float max2f(float a,float b){float r;asm("v_max_f32_e32 %0, %1, %2":"=v"(r):"v"(a),"v"(b));return r;}
__device__ __forceinline__ float fadd_s(float a,float b){float r;asm("v_add_f32_e32 %0, %1, %2":"=v"(r):"v"(a),"v"(b));return r;}
__device__ __forceinline__ float fsub_s(float a,float b){float r;asm("v_sub_f32_e32 %0, %1, %2":"=v"(r):"v"(a),"v"(b));return r;}
typedef float f32x2_t __attribute__((ext_vector_type(2))); typedef __bf16 bf16x2_t __attribute__((ext_vector_type(2)));
__device__ __forceinline__ unsigned cvtpk_s(float lo,float hi){f32x2_t v={lo,hi};bf16x2_t b=__builtin_convertvector(v,bf16x2_t);return __builtin_bit_cast(unsigned,b);}
#define WAIT_BAR(N) asm volatile("s_waitcnt vmcnt(" #N ") lgkmcnt(0)\n\ts_barrier":::"memory")

__device__ __forceinline__ void qkt(f32x16&p0,f32x16&p1,const char*Kslot,const bf16x8*qr,const f32x16&negm,int r32,int hi){
  const char*kb=Kslot+hi*1024+r32*16;
  #pragma unroll
  for(int d0=0;d0<4;++d0){
    const bf16x8 b0=*reinterpret_cast<const bf16x8*>(kb+d0*2048);
    const bf16x8 b1=*reinterpret_cast<const bf16x8*>(kb+d0*2048+512);
    if(d0==0){p0=__builtin_amdgcn_mfma_f32_32x32x16_bf16(b0,qr[0],negm,0,0,0);p1=__builtin_amdgcn_mfma_f32_32x32x16_bf16(b1,qr[0],negm,0,0,0);}
    else{p0=__builtin_amdgcn_mfma_f32_32x32x16_bf16(b0,qr[d0],p0,0,0,0);p1=__builtin_amdgcn_mfma_f32_32x32x16_bf16(b1,qr[d0],p1,0,0,0);}}
}
typedef __attribute__((address_space(3))) const char* lds_cptr;
typedef short v4i16_t __attribute__((ext_vector_type(4)));
__device__ __forceinline__ void kload8(bf16x8*kf,lds_cptr kp){
  kf[0]=*(const __attribute__((address_space(3))) bf16x8*)(kp);      kf[1]=*(const __attribute__((address_space(3))) bf16x8*)(kp+512);
  kf[2]=*(const __attribute__((address_space(3))) bf16x8*)(kp+2048); kf[3]=*(const __attribute__((address_space(3))) bf16x8*)(kp+2560);
  kf[4]=*(const __attribute__((address_space(3))) bf16x8*)(kp+4096); kf[5]=*(const __attribute__((address_space(3))) bf16x8*)(kp+4608);
  kf[6]=*(const __attribute__((address_space(3))) bf16x8*)(kp+6144); kf[7]=*(const __attribute__((address_space(3))) bf16x8*)(kp+6656);
}
__device__ __forceinline__ void kload2(bf16x8*kf,lds_cptr kp,int j){ kf[2*j]=*(const __attribute__((address_space(3))) bf16x8*)(kp+j*2048); kf[2*j+1]=*(const __attribute__((address_space(3))) bf16x8*)(kp+j*2048+512); }
__device__ __forceinline__ s16x4 vtr(lds_cptr p){ return __builtin_bit_cast(s16x4,__builtin_amdgcn_ds_read_tr16_b64_v4i16((__attribute__((address_space(3))) v4i16_t*)p)); }
__device__ __forceinline__ float rowmax(const f32x16&p0,const f32x16&p1){
  float a=max3f(p0[0],p0[1],p1[0]),b=max3f(p0[2],p0[3],p1[1]);a=max3f(a,p1[2],p1[3]);
  #pragma unroll
  for(int r=4;r<16;r+=4){a=max3f(a,p0[r],p0[r+1]);b=max3f(b,p0[r+2],p0[r+3]);a=max3f(a,p1[r],p1[r+1]);b=max3f(b,p1[r+2],p1[r+3]);}
  const float m=max2f(a,b);
  auto rr=__builtin_amdgcn_permlane32_swap(__float_as_uint(m),__float_as_uint(m),false,false);
  return max2f(__uint_as_float(rr[0]),__uint_as_float(rr[1]));
}
__device__ __forceinline__ void pv(f32x16*o,int vb,bf16x8 pa0,bf16x8 pa1,bf16x8 pa2,bf16x8 pa3){
  #pragma unroll
  for(int d0=0;d0<2;++d0){s16x4 lo[4],hi[4];
    #pragma unroll
    for(int ks=0;ks<4;++ks){
      asm volatile("ds_read_b64_tr_b16 %0,%1 offset:%c2":"=&v"(lo[ks]):"v"(vb),"i"(d0*4096+ks*1024):"memory");
      asm volatile("ds_read_b64_tr_b16 %0,%1 offset:%c2":"=&v"(hi[ks]):"v"(vb),"i"(d0*4096+ks*1024+512):"memory");}
    asm volatile("s_waitcnt lgkmcnt(0)":::"memory");SBAR();
    #define PK(k) (bf16x8){lo[k][0],lo[k][1],lo[k][2],lo[k][3],hi[k][0],hi[k][1],hi[k][2],hi[k][3]}
    o[d0]=__builtin_amdgcn_mfma_f32_32x32x16_bf16(pa0,PK(0),o[d0],0,0,0);
    o[d0]=__builtin_amdgcn_mfma_f32_32x32x16_bf16(pa1,PK(1),o[d0],0,0,0);
    o[d0]=__builtin_amdgcn_mfma_f32_32x32x16_bf16(pa2,PK(2),o[d0],0,0,0);
    o[d0]=__builtin_amdgcn_mfma_f32_32x32x16_bf16(pa3,PK(3),o[d0],0,0,0);
    #undef PK
  }
}

#ifndef ATTN_STORE16
#define ATTN_STORE16(p,v) (*(u32x4*)(p)=(v))
#endif
template<int MODE,int THRL> __device__ __forceinline__ void attn_unit(int b,int h,int qb,const bf16*Q,const bf16*__restrict__ K,const bf16*__restrict__ V,bf16*O,float*SSQ,int hidx,const float*cbg,char*shm){
  int tid_=threadIdx.x; asm volatile("":"+v"(tid_));
  const int tid=tid_,lane=tid&63,r32=lane&31,hi=lane>>5; const int wid=__builtin_amdgcn_readfirstlane(tid>>6);
  const long rowbase=(long)b*SEQ; const int q0=qb*QB; const int tlo=(MODE==1)?((4*qb-8)>0?(4*qb-8):0):0;
  const bf16*Qw=Q+(rowbase+q0+wid*QBLK)*DM+h*D;
  const bf16*Kh=K+(rowbase+tlo*KVBLK)*DM+h*D,*Vh=V+(rowbase+tlo*KVBLK)*DM+h*D;
  const unsigned lds0=(unsigned)(uintptr_t)shm;
  float*wsf=(float*)(shm+LDS_WS)+wid*64;
  const bf16*ksrc=Kh+(long)lane*DM+wid*8;
  const bf16*vsrc=Vh+(long)(16*(wid&3)+(lane>>2))*DM+(wid>>2)*32+(lane&3)*8;
  const unsigned kdst=lds0+LDS_K+wid*1024, vdst=lds0+LDS_V+wid*1024;
  #define DMA_K(t,slot) glds16(ksrc+(long)(t)*KVBLK*DM,(unsigned)__builtin_amdgcn_readfirstlane(kdst+(slot)))
  #define DMA_V(t,slot) glds16(vsrc+(long)(t)*KVBLK*DM,(unsigned)__builtin_amdgcn_readfirstlane(vdst+(slot)))
  const int vb0=(int)(lds0+LDS_V)+((lane>>4)&1)*32+(lane&3)*8+(4*hi+((lane&15)>>2))*64;
  const char*Kbase=shm+LDS_K; bf16x8 kf[8];
  const lds_cptr shm3=(lds_cptr)shm; const lds_cptr kp0=shm3+LDS_K+hi*1024+r32*16; const lds_cptr vp0=shm3+LDS_V+((lane>>4)&1)*32+(lane&3)*8+(4*hi+((lane&15)>>2))*64;
  const int NT=(q0+QB)/KVBLK-tlo;
  glds16(cbg+wid*256+lane*4,(unsigned)__builtin_amdgcn_readfirstlane(lds0+LDS_CB+wid*1024));
  DMA_K(0,0);DMA_V(0,0);DMA_K(1,SLOTB);
  bf16x8 qr[4];
  #pragma unroll
  for(int d0=0;d0<4;++d0)qr[d0]=*reinterpret_cast<const bf16x8*>(&Qw[(long)r32*DM+d0*16+hi*8]);
  float mhat=0.f,l_reg=0.f;f32x16 o[2];o[0]=f32x16{};o[1]=f32x16{};f32x16 negm=f32x16{};asm volatile("":"+v"(negm));
  const int qrel=wid*QBLK+r32;
  typedef __attribute__((address_space(3))) const float* lds_fptr; typedef float f32x4a __attribute__((ext_vector_type(4)));
  const lds_fptr cb3=(lds_fptr)(shm3+LDS_CB); const float NEGB=-8192.f;
  const int cw=4*qb+(wid>>1);
  const int qabs=q0+wid*QBLK+r32;
  #define CMASK(P0,P1,t) do{int jb_=(t)-(NT-4); if(MODE==0&&jb_>=0)cmask(P0,P1,jb_,qrel,hi);}while(0)
  #define POST(P0,P1,t) do{ if(NOPOST){} else \
    if(MODE==0){ const lds_fptr cp_=cb3+(t)*64+4*hi; \
      _Pragma("unroll") for(int g_=0;g_<4;++g_){ const f32x4a a_=*(const __attribute__((address_space(3))) f32x4a*)(cp_+8*g_); const f32x4a b_=*(const __attribute__((address_space(3))) f32x4a*)(cp_+32+8*g_); \
        _Pragma("unroll") for(int i_=0;i_<4;++i_){P0[4*g_+i_]+=a_[i_];P1[4*g_+i_]+=b_[i_];} } \
    } else { const int tabs_=tlo+(t); const int j_=cw-tabs_; \
      if(j_<0||j_>8){ _Pragma("unroll") for(int r_=0;r_<16;++r_){P0[r_]=NEGB;P1[r_]=NEGB;} } \
      else if(j_<=2){ const int base_=qabs-64*tabs_-4*hi; \
        _Pragma("unroll") for(int r_=0;r_<16;++r_){ const int d0_=base_-((r_&3)+8*(r_>>2)); const int i0_=(d0_<128?d0_:128)+128; const int d1_=d0_-32; const int i1_=(d1_<128?d1_:128)+128; \
          P0[r_]+=cb3[i0_]; P1[r_]+=cb3[i1_]; } } \
    } }while(0)
  bool resc=false;
  #define START(P0,P1) do{ const float rm=rowmax(P0,P1); resc=false; \
    { const float dl=rm; mhat=fadd_s(mhat,dl); \
      _Pragma("unroll") for(int r=0;r<16;++r){P0[r]=fsub_s(P0[r],dl);P1[r]=fsub_s(P1[r],dl);} \
      _Pragma("unroll") for(int r=0;r<16;++r)negm[r]=-mhat; asm volatile("":"+v"(negm)); } \
    _Pragma("unroll") for(int r=0;r<16;++r)P0[r]=__builtin_amdgcn_exp2f(P0[r]); }while(0)
  #define RESC() do{ if(resc){ asm volatile("s_waitcnt lgkmcnt(0)":::"memory"); \
      _Pragma("unroll") for(int d_=0;d_<2;++d_) _Pragma("unroll") for(int r=0;r<16;++r)o[d_][r]*=wsf[crow(r,hi)]; } }while(0)
  f32x16 pA0,pA1,pB0,pB1;
  int sl_prev=0,sl_cur=0,sl_next=SLOTB;
  #define ROT() do{sl_prev=sl_cur;sl_cur=sl_next;sl_next=(sl_next==(NSLOT-1)*SLOTB)?0:sl_next+SLOTB;}while(0)
  DMA_K(2,2*SLOTB);
  WAIT_BAR(3);
  qkt(pA0,pA1,Kbase,qr,negm,r32,hi);asm volatile("s_nop 15\n\ts_nop 7":"+v"(pA0),"+v"(pA1));POST(pA0,pA1,0);CMASK(pA0,pA1,0);
  START(pA0,pA1);
  _Pragma("unroll") for(int r=0;r<16;++r)pA1[r]=__builtin_amdgcn_exp2f(pA1[r]);
  WAIT_BAR(0);
  DMA_K(3,0);DMA_V(1,SLOTB);
  ROT();
  kload8(kf,kp0+sl_cur);
  WAIT_BAR(2);
  s16x4 vlo[8],vhi[8]; u32x4 pw0,pw1,pw2,pw3;
  #define PKW(P,B) cvtpk_s(P[B],P[B+1])
  #define PAF(k) __builtin_bit_cast(bf16x8,pw##k)
  #define VFR(i) (bf16x8){vlo[i][0],vlo[i][1],vlo[i][2],vlo[i][3],vhi[i][0],vhi[i][1],vhi[i][2],vhi[i][3]}
  #define PIN(x) asm volatile("":"+v"(x))
  #define MX3(a,b,c) __builtin_fmaxf(__builtin_fmaxf((a),(b)),(c))
  #define GAPA(MF,A0,A1,A2,A3,W0,W1,PW) do{ MF; sacc+=A0; sacc+=A1; sacc+=A2; sacc+=A3; PIN(sacc); W0; W1; PIN(PW); SBAR(); }while(0)
  #define EX(v) __builtin_amdgcn_exp2f(v)
  #define GAPB(MF,X,B) do{ MF; X[B]=EX(X[B]); X[B+1]=EX(X[B+1]); X[B+2]=EX(X[B+2]); X[B+3]=EX(X[B+3]); PIN(X); SBAR(); }while(0)
  #define VRD(i) do{ vlo[i]=vtr(vp_+(((i)>>2)*4096+((i)&3)*1024)); vhi[i]=vtr(vp_+(((i)>>2)*4096+((i)&3)*1024+512)); }while(0)
  #define KRD(G,j) do{ if(G){ kload2(kf,kp0+sl_next,j); SBAR(); } }while(0)
  #define STEP(C0,C1,P0,P1,t,GK,GV,GL) do{ SBAR(); \
    const lds_cptr vp_=vp0+sl_prev; \
    VRD(0); SBAR(); float sacc=(P0[0]+P0[1]); \
    GAPA(C0=__builtin_amdgcn_mfma_f32_32x32x16_bf16(kf[0],qr[0],negm,0,0,0), P0[2],P0[3],P0[4],P0[5],     pw0[0]=PKW(P0,0), pw0[1]=PKW(P0,2), pw0); \
    VRD(4); SBAR(); GAPA(C1=__builtin_amdgcn_mfma_f32_32x32x16_bf16(kf[1],qr[0],negm,0,0,0), P0[6],P0[7],P0[8],P0[9],     pw0[2]=PKW(P0,4), pw0[3]=PKW(P0,6), pw0); \
    VRD(1); SBAR(); GAPA(C0=__builtin_amdgcn_mfma_f32_32x32x16_bf16(kf[2],qr[1],C0,0,0,0),   P0[10],P0[11],P0[12],P0[13], pw1[0]=PKW(P0,8), pw1[1]=PKW(P0,10), pw1); \
    VRD(5); SBAR(); GAPA(C1=__builtin_amdgcn_mfma_f32_32x32x16_bf16(kf[3],qr[1],C1,0,0,0),   P0[14],P0[15],P1[0],P1[1],   pw1[2]=PKW(P0,12),pw1[3]=PKW(P0,14), pw1); \
    VRD(2); SBAR(); GAPA(C0=__builtin_amdgcn_mfma_f32_32x32x16_bf16(kf[4],qr[2],C0,0,0,0),   P1[2],P1[3],P1[4],P1[5],     pw2[0]=PKW(P1,0), pw2[1]=PKW(P1,2), pw2); \
    VRD(6); SBAR(); GAPA(C1=__builtin_amdgcn_mfma_f32_32x32x16_bf16(kf[5],qr[2],C1,0,0,0),   P1[6],P1[7],P1[8],P1[9],     pw2[2]=PKW(P1,4), pw2[3]=PKW(P1,6), pw2); \
    VRD(3); SBAR(); GAPA(C0=__builtin_amdgcn_mfma_f32_32x32x16_bf16(kf[6],qr[3],C0,0,0,0),   P1[10],P1[11],P1[12],P1[13], pw3[0]=PKW(P1,8), pw3[1]=PKW(P1,10), pw3); \
    VRD(7); SBAR(); GAPA(C1=__builtin_amdgcn_mfma_f32_32x32x16_bf16(kf[7],qr[3],C1,0,0,0),   P1[14],P1[15],0.f,0.f,       pw3[2]=PKW(P1,12),pw3[3]=PKW(P1,14), pw3); \
    l_reg+=sacc; \
    if(GK){DMA_K((t)+3,sl_cur);} if(GV){DMA_V((t)+1,sl_next);} \
    POST(C0,C1,t); CMASK(C0,C1,t); \
    { float a=MX3(C0[0],C0[1],C1[0]),b=MX3(C0[2],C0[3],C1[1]); a=MX3(a,C1[2],C1[3]); \
      _Pragma("unroll") for(int r=4;r<16;r+=4){a=MX3(a,C0[r],C0[r+1]);b=MX3(b,C0[r+2],C0[r+3]);a=MX3(a,C1[r],C1[r+1]);b=MX3(b,C1[r+2],C1[r+3]);} \
      float rm=__builtin_fmaxf(a,b); { auto rr=__builtin_amdgcn_permlane32_swap(__float_as_uint(rm),__float_as_uint(rm),false,false); rm=__builtin_fmaxf(__uint_as_float(rr[0]),__uint_as_float(rr[1])); } \
      resc=false; \
      if(__builtin_expect(__any(rm>(float)THRL),0)){ const float dl=__builtin_fmaxf(rm,0.f); mhat+=dl; \
        _Pragma("unroll") for(int r=0;r<16;++r){C0[r]-=dl;C1[r]-=dl;} \
        _Pragma("unroll") for(int r=0;r<16;++r)negm[r]=-mhat; asm volatile("":"+v"(negm)); \
        const float f=__builtin_amdgcn_exp2f(-dl); l_reg*=f; if(hi==0)wsf[r32]=f; resc=true; } } \
    SBAR(); \
    GAPB(o[0]=__builtin_amdgcn_mfma_f32_32x32x16_bf16(PAF(0),VFR(0),o[0],0,0,0), C0,0); \
    GAPB(o[1]=__builtin_amdgcn_mfma_f32_32x32x16_bf16(PAF(0),VFR(4),o[1],0,0,0), C0,4); \
    KRD(GL,0); GAPB(o[0]=__builtin_amdgcn_mfma_f32_32x32x16_bf16(PAF(1),VFR(1),o[0],0,0,0), C0,8); \
    KRD(GL,1); GAPB(o[1]=__builtin_amdgcn_mfma_f32_32x32x16_bf16(PAF(1),VFR(5),o[1],0,0,0), C0,12); \
    KRD(GL,2); GAPB(o[0]=__builtin_amdgcn_mfma_f32_32x32x16_bf16(PAF(2),VFR(2),o[0],0,0,0), C1,0); \
    KRD(GL,3); GAPB(o[1]=__builtin_amdgcn_mfma_f32_32x32x16_bf16(PAF(2),VFR(6),o[1],0,0,0), C1,4); \
    GAPB(o[0]=__builtin_amdgcn_mfma_f32_32x32x16_bf16(PAF(3),VFR(3),o[0],0,0,0), C1,8); \
    GAPB(o[1]=__builtin_amdgcn_mfma_f32_32x32x16_bf16(PAF(3),VFR(7),o[1],0,0,0), C1,12); \
    }while(0)
  int t=1;
  #undef CMASK
  #define CMASK(P0,P1,t) do{}while(0)
  for(;t+5<NT;t+=2){
    STEP(pB0,pB1,pA0,pA1,t,true,true,true);     WAIT_BAR(2); RESC(); ROT();
    STEP(pA0,pA1,pB0,pB1,t+1,true,true,true);   WAIT_BAR(2); RESC(); ROT();
  }
  #undef CMASK
  #define CMASK(P0,P1,t) do{int jb_=(t)-(NT-4); if(MODE==0&&jb_>=0)cmask(P0,P1,jb_,qrel,hi);}while(0)
  #define ENDW(tt) do{ if((tt)+3<NT){WAIT_BAR(2);} else if((tt)+2<NT){WAIT_BAR(1);} else {WAIT_BAR(0);} }while(0)
  for(;t+1<NT;t+=2){
    STEP(pB0,pB1,pA0,pA1,t,(t+3<NT),(t+1<NT),(t+1<NT));       ENDW(t);   RESC(); ROT();
    STEP(pA0,pA1,pB0,pB1,t+1,(t+4<NT),(t+2<NT),(t+2<NT));     ENDW(t+1); RESC(); ROT();
  }
  STEP(pB0,pB1,pA0,pA1,NT-1,false,false,false); RESC();
  { float sacc=pB0[0]+pB0[1]; _Pragma("unroll") for(int r=2;r<16;++r)sacc+=pB0[r]; _Pragma("unroll") for(int r=0;r<16;++r)sacc+=pB1[r]; l_reg+=sacc;
    pw0=(u32x4){PKW(pB0,0),PKW(pB0,2),PKW(pB0,4),PKW(pB0,6)};pw1=(u32x4){PKW(pB0,8),PKW(pB0,10),PKW(pB0,12),PKW(pB0,14)};pw2=(u32x4){PKW(pB1,0),PKW(pB1,2),PKW(pB1,4),PKW(pB1,6)};pw3=(u32x4){PKW(pB1,8),PKW(pB1,10),PKW(pB1,12),PKW(pB1,14)};
    SBAR(); pv(o,vb0+sl_cur,PAF(0),PAF(1),PAF(2),PAF(3)); }
  #undef PKW
  #undef PAF
  #undef VFR
  #undef PIN
  #undef MX3
  #undef GAPA
  #undef GAPB
  #undef EX
  #undef VRD
  #undef KRD
  #undef STEP
  #undef ENDW
  {auto rr=__builtin_amdgcn_permlane32_swap(__float_as_uint(l_reg),__float_as_uint(l_reg),false,false);l_reg=__uint_as_float(rr[0])+__uint_as_float(rr[1]);}
  if(hi==0)wsf[32+r32]=l_reg;asm volatile("s_waitcnt lgkmcnt(0)":::"memory");
  float rli[16];
  #pragma unroll
  for(int r=0;r<16;++r)rli[r]=__builtin_amdgcn_rcpf(wsf[32+crow(r,hi)]);
  bf16*Ow=O+(rowbase+q0+wid*QBLK)*DMO+h*D;
  { bf16*stg=(bf16*)(shm+LDS_OST)+wid*2048;
    #pragma unroll
    for(int r=0;r<16;++r){const int orow=crow(r,hi);
      #pragma unroll
      for(int d0=0;d0<2;++d0)stg[orow*64+d0*32+r32]=__float2bfloat16(o[d0][r]*rli[r]);}
    asm volatile("s_waitcnt lgkmcnt(0)":::"memory");
    #pragma unroll
    for(int i=0;i<4;++i){const int row=i*8+(lane>>3),ch=lane&7; const u32x4 v=*(const u32x4*)(stg+row*64+ch*8); ATTN_STORE16(Ow+(long)row*DMO+ch*8,v);
      if(!NOSSQ){float sq=0.f;
      #pragma unroll
      for(int e=0;e<4;++e){const float lo_=__uint_as_float(v[e]<<16),hi_=__uint_as_float(v[e]&0xffff0000u);sq+=lo_*lo_+hi_*hi_;}
      sq+=__shfl_xor(sq,1);sq+=__shfl_xor(sq,2);sq+=__shfl_xor(sq,4);
      if(ch==0)SSQ[(rowbase+q0+wid*QBLK+row)*16+hidx]=sq;}} }
  asm volatile("s_waitcnt lgkmcnt(0)\n\ts_barrier":::"memory");
  #undef DMA_K
  #undef DMA_V
  #undef POST
  #undef CMASK
  #undef START
  #undef RESC
  #undef ROT
}
constexpr int ATTN_LDS_BYTES=LDS_TOTAL;
#undef SBAR
#undef WAIT_BAR
}
constexpr int NWAVES = 8;
constexpr size_t MiB = 1u << 20;
constexpr size_t WS_WIN = 2 * MiB, WS_WOUT = 8 * MiB, WS_WGU = 10 * MiB, WS_WDN = 21 * MiB;
constexpr size_t WS_CBP = 28 * MiB, WS_CBS = 29 * MiB, WS_TAB = 29 * MiB + 512 * 1024, WS_SSQ = 30 * MiB;
constexpr size_t WS_CTL = 0, WS_MIXS = 32 * MiB + 256 * 1024;
constexpr size_t WS_XN = 33 * MiB;
constexpr size_t WS_XN2 = 98 * MiB;
constexpr size_t WS_QKV = 163 * MiB;
constexpr size_t WS_FF = 357 * MiB;
constexpr size_t WS_END = 487 * MiB;
static_assert(WS_XN + (size_t)MPAD * 1024 * 2 <= WS_XN2 && WS_XN2 + (size_t)MPAD * 1024 * 2 <= WS_QKV && WS_QKV + (size_t)MPAD * 3072 * 2 <= WS_FF && WS_FF + (size_t)MPAD * 1024 * 4 <= WS_END, "ws map");
static_assert(WS_SSQ + (size_t)MPAD * 16 * 4 <= WS_XN && WS_WDN + (size_t)1024 * DFF * 2 <= WS_CBP && WS_WGU + (size_t)NGU * 1024 * 2 <= WS_WDN, "ws map 2");
constexpr int RING_BYTES = 131072, TAB_OFF = RING_BYTES  , LDS_BYTES = 147456;

#define LAS __attribute__((address_space(3)))
typedef unsigned short bf16;
typedef unsigned v4u __attribute__((ext_vector_type(4)));
typedef float f32x4 __attribute__((ext_vector_type(4)));
__device__ __forceinline__ unsigned f2bf(float f) { unsigned u = __builtin_bit_cast(unsigned, f); return (u + 0x7fffu + ((u >> 16) & 1u)) >> 16; }
__device__ __forceinline__ unsigned pk2(float lo, float hi) { return f2bf(lo) | (f2bf(hi) << 16); }
__device__ __forceinline__ float bf2f(bf16 b) { return __uint_as_float((unsigned)b << 16); }
__device__ __forceinline__ float wave_sum(float v) {
#pragma unroll
    for (int o = 1; o < 64; o <<= 1) v += __shfl_xor(v, o);
    return v;
}
__device__ __forceinline__ float wave_max(float v) {
#pragma unroll
    for (int o = 1; o < 64; o <<= 1) v = fmaxf(v, __shfl_xor(v, o));
    return v;
}

#ifndef PH
#define PH 255
#endif
#ifndef AM
#define AM 7
#endif
struct Args { const float* in[20]; float* out; unsigned char* ws; };

__device__ __forceinline__ void p0_transpose_item(const float* src, int ldw, bf16* dst, int Kd, const float* kscale, LAS float* scr, int lane) {
#pragma unroll 8
    for (int i = 0; i < 32; ++i) { const int kk = 2 * i + (lane >> 5); float v = src[(size_t)kk * ldw + (lane & 31)]; if (kscale) v *= kscale[kk]; scr[kk * 33 + (lane & 31)] = v; }
    asm volatile("s_waitcnt lgkmcnt(0)" ::: "memory");
    const int c = lane & 7;
#pragma unroll
    for (int j = 0; j < 4; ++j) { const int n = (lane >> 3) + 8 * j; const LAS float* s = scr + (8 * c) * 33 + n;
        v4u o; o.x = pk2(s[0 * 33], s[1 * 33]); o.y = pk2(s[2 * 33], s[3 * 33]); o.z = pk2(s[4 * 33], s[5 * 33]); o.w = pk2(s[6 * 33], s[7 * 33]);
        *(v4u*)(dst + (size_t)n * Kd + 8 * c) = o; }
    asm volatile("s_waitcnt lgkmcnt(0)" ::: "memory");
}

__device__ __forceinline__ void sample_attn_item(const Args& a, unsigned char* ws, LAS unsigned char* lds, int item) {
    int tid_ = threadIdx.x; asm volatile("" : "+v"(tid_)); const int tid = tid_, lane = tid & 63, wave = __builtin_amdgcn_readfirstlane(tid >> 6);
    const int type = item >> 6, s = (item >> 3) & 7, h = item & 7;
    const int ncache = type ? BLEN : PAST, nk = ncache + STOK;
    const float* Kc = (type ? a.in[5] : a.in[2]) + (size_t)s * ncache * 512 + h * 64;
    const float* Vc = (type ? a.in[6] : a.in[3]) + (size_t)s * ncache * 512 + h * 64;
    const float* Kn = a.out + (type ? O_BKS : O_AKS) + (size_t)s * STOK * 512 + h * 64;
    const float* Vn = a.out + (type ? O_BVS : O_AVS) + (size_t)s * STOK * 512 + h * 64;
    const bf16* QKV = (const bf16*)(ws + WS_QKV);
    bf16* O = (bf16*)(ws + WS_XN);
    float* SSQ = (float*)(ws + WS_SSQ);
    const float* cbg = type ? (const float*)(ws + WS_TAB) + h * 2048 : (const float*)(ws + WS_CBS) + (size_t)(s * 8 + h) * 1040;
    LAS float* QL = (LAS float*)lds;
    LAS float* SC = (LAS float*)(lds + 4096);
    constexpr int SCP = 1088;
    for (int e = tid; e < 1024; e += 512) { const int i = e >> 6, d = e & 63; QL[e] = bf2f(QKV[(size_t)(MP + s * STOK + i) * NQKV + (type ? 1536 : 0) + h * 64 + d]); }
    __syncthreads();
    const int i0 = 2 * wave, i1 = i0 + 1;
    float m0 = -INFINITY, m1 = -INFINITY;
    for (int blk = 0; blk * 64 < nk; ++blk) {
        const int j = blk * 64 + lane;
        if (j < nk) {
            const float* kr = j < ncache ? Kc + (size_t)j * 512 : Kn + (size_t)(j - ncache) * 512;
            float s0 = 0.f, s1 = 0.f;
#pragma unroll
            for (int d = 0; d < 64; d += 4) { const f32x4 kv = *(const f32x4*)(kr + d); const f32x4 qa = *(const LAS f32x4*)(QL + i0 * 64 + d), qb = *(const LAS f32x4*)(QL + i1 * 64 + d);
                s0 += kv[0] * qa[0] + kv[1] * qa[1] + kv[2] * qa[2] + kv[3] * qa[3]; s1 += kv[0] * qb[0] + kv[1] * qb[1] + kv[2] * qb[2] + kv[3] * qb[3]; }
            if (type == 0) { const float bb = cbg[j]; s0 += bb; s1 += bb; if (j > ncache + i0) s0 = -INFINITY; if (j > ncache + i1) s1 = -INFINITY; }
            else { int d0 = i0 + BLEN - j; d0 = d0 < -128 ? -128 : (d0 > 128 ? 128 : d0); int d1 = i1 + BLEN - j; d1 = d1 < -128 ? -128 : (d1 > 128 ? 128 : d1); s0 += cbg[d0 + 128]; s1 += cbg[d1 + 128]; }
            SC[i0 * SCP + j] = s0; SC[i1 * SCP + j] = s1; m0 = fmaxf(m0, s0); m1 = fmaxf(m1, s1);
        }
    }
    m0 = wave_max(m0); m1 = wave_max(m1);
    float l0 = 0.f, l1 = 0.f;
    for (int blk = 0; blk * 64 < nk; ++blk) { const int j = blk * 64 + lane;
        if (j < nk) { const float p0 = __builtin_amdgcn_exp2f(SC[i0 * SCP + j] - m0), p1 = __builtin_amdgcn_exp2f(SC[i1 * SCP + j] - m1); SC[i0 * SCP + j] = p0; SC[i1 * SCP + j] = p1; l0 += p0; l1 += p1; } }
    l0 = wave_sum(l0); l1 = wave_sum(l1);
    __syncthreads();
    float o0 = 0.f, o1 = 0.f;
    for (int j = 0; j < nk; j += 4) {
        const float* vr = j < ncache ? Vc + (size_t)j * 512 : Vn + (size_t)(j - ncache) * 512;
        const f32x4 pa = *(const LAS f32x4*)(SC + i0 * SCP + j), pb = *(const LAS f32x4*)(SC + i1 * SCP + j);
        const float v0 = vr[lane], v1 = vr[512 + lane], v2 = vr[1024 + lane], v3 = vr[1536 + lane];
        o0 += pa[0] * v0 + pa[1] * v1 + pa[2] * v2 + pa[3] * v3; o1 += pb[0] * v0 + pb[1] * v1 + pb[2] * v2 + pb[3] * v3;
    }
    o0 /= l0; o1 /= l1;
    const unsigned b0 = f2bf(o0), b1 = f2bf(o1);
    const size_t r0 = (size_t)(MP + s * STOK + i0), r1 = r0 + 1;
    O[r0 * 1024 + type * 512 + h * 64 + lane] = (bf16)b0; O[r1 * 1024 + type * 512 + h * 64 + lane] = (bf16)b1;
    const float f0 = __uint_as_float(b0 << 16), f1 = __uint_as_float(b1 << 16);
    const float q0 = wave_sum(f0 * f0), q1 = wave_sum(f1 * f1);
    if (lane == 0) { SSQ[r0 * 16 + type * 8 + h] = q0; SSQ[r1 * 16 + type * 8 + h] = q1; }
    __syncthreads();
}


__device__ __forceinline__ void rowpass_mix(const float* mixrow, const float* xrow, float* yrow, bf16* xn2row, const f32x4 (&g1)[4], const f32x4 (&g2)[4], int lane) {
    const f32x4* mr = (const f32x4*)mixrow + lane; const f32x4* xr = (const f32x4*)xrow + lane;
    f32x4 v[4], x[4]; float ss = 0.f;
#pragma unroll
    for (int j = 0; j < 4; ++j) { v[j] = mr[64 * j]; x[j] = xr[64 * j]; ss += (v[j][0] * v[j][0] + v[j][1] * v[j][1]) + (v[j][2] * v[j][2] + v[j][3] * v[j][3]); }
    const float rstd = 1.0f / sqrtf(wave_sum(ss) * (1.f / 1024.f) + EPS);
    float s2 = 0.f; f32x4* yr = (f32x4*)yrow + lane;
#pragma unroll
    for (int j = 0; j < 4; ++j) { x[j] = x[j] + v[j] * rstd * g1[j]; yr[64 * j] = x[j]; s2 += (x[j][0] * x[j][0] + x[j][1] * x[j][1]) + (x[j][2] * x[j][2] + x[j][3] * x[j][3]); }
    const float r2 = 1.0f / sqrtf(wave_sum(s2) * (1.f / 1024.f) + EPS);
    unsigned long long* o8 = (unsigned long long*)xn2row + lane;
#pragma unroll
    for (int j = 0; j < 4; ++j) { const f32x4 t = x[j] * r2 * g2[j]; o8[64 * j] = (unsigned long long)pk2(t[0], t[1]) | ((unsigned long long)pk2(t[2], t[3]) << 32); }
}
__device__ __forceinline__ void rowpass_ff(const float* ffrow, float* yrow, const f32x4 (&g3)[4], int lane) {
    const f32x4* fr = (const f32x4*)ffrow + lane; f32x4* yr = (f32x4*)yrow + lane;
    f32x4 v[4], x[4]; float ss = 0.f;
#pragma unroll
    for (int j = 0; j < 4; ++j) { v[j] = fr[64 * j]; x[j] = yr[64 * j]; ss += (v[j][0] * v[j][0] + v[j][1] * v[j][1]) + (v[j][2] * v[j][2] + v[j][3] * v[j][3]); }
    const float rstd = 1.0f / sqrtf(wave_sum(ss) * (1.f / 1024.f) + EPS);
#pragma unroll
    for (int j = 0; j < 4; ++j) yr[64 * j] = x[j] + v[j] * rstd * g3[j];
}

typedef short bf16x8v __attribute__((ext_vector_type(8)));
__device__ __forceinline__ void skinny_k(const bf16* Arow, const bf16* B0row, const bf16* B1row, int ksteps, f32x4& acc0, f32x4& acc1) {
    const bf16x8v* ap = (const bf16x8v*)Arow; const bf16x8v* b0p = (const bf16x8v*)B0row; const bf16x8v* b1p = (const bf16x8v*)B1row;
#pragma unroll 4
    for (int ks = 0; ks < ksteps; ++ks) { const bf16x8v av = ap[4 * ks], b0 = b0p[4 * ks], b1 = b1p[4 * ks];
        acc0 = __builtin_amdgcn_mfma_f32_16x16x32_bf16(b0, av, acc0, 0, 0, 0); acc1 = __builtin_amdgcn_mfma_f32_16x16x32_bf16(b1, av, acc1, 0, 0, 0); }
}
__device__ __forceinline__ bool last_arriver(unsigned* cnt, unsigned total, LAS unsigned* flag, int tid) {
    __threadfence(); __syncthreads();
    if (tid == 0) { const unsigned old = __hip_atomic_fetch_add(cnt, 1u, __ATOMIC_RELAXED, __HIP_MEMORY_SCOPE_AGENT); *flag = (old == total - 1u) ? 1u : 0u; }
    __syncthreads();
    const bool last = *flag != 0u;
    if (last) __threadfence();
    return last;
}
#define SK_TID() int tid_ = threadIdx.x; asm volatile("" : "+v"(tid_)); const int tid = tid_, lane = tid & 63, wave = __builtin_amdgcn_readfirstlane(tid >> 6), fr = lane & 15, fq = lane >> 4, row = 16 * wave + fr; (void)tid
__device__ __forceinline__ void s1_slab(int j, const bf16* XN, const bf16* Win_t, bf16* QKV, float* out) {
    SK_TID();
    f32x4 acc[2] = {(f32x4){0.f, 0.f, 0.f, 0.f}, (f32x4){0.f, 0.f, 0.f, 0.f}};
    skinny_k(XN + (size_t)(MP + row) * 1024 + 8 * fq, Win_t + (size_t)(32 * j + fr) * 1024 + 8 * fq, Win_t + (size_t)(32 * j + 16 + fr) * 1024 + 8 * fq, 32, acc[0], acc[1]);
    const int type = (32 * j) >> 9; const float sc = (type == 0 || type == 3) ? C2 : 1.f;
    float* fb = (type == 1) ? out + O_AKS : (type == 2) ? out + O_AVS : (type == 4) ? out + O_BKS : (type == 5) ? out + O_BVS : nullptr;
#pragma unroll
    for (int f = 0; f < 2; ++f) { const int col = 32 * j + 16 * f + 4 * fq; const f32x4 v = acc[f];
        if (fb) *(f32x4*)(fb + (size_t)row * 512 + (col & 511)) = v;
        *(unsigned long long*)(QKV + (size_t)(MP + row) * NQKV + col) = (unsigned long long)pk2(v[0] * sc, v[1] * sc) | ((unsigned long long)pk2(v[2] * sc, v[3] * sc) << 32); }
}
__device__ __forceinline__ void s3_slab(int j, const bf16* O, const bf16* Wout_t, const float* SSQ, float* MIXS) {
    SK_TID();
    const f32x4* sp = (const f32x4*)(SSQ + (size_t)(MP + row) * 16); const f32x4 s0 = sp[0], s1 = sp[1], s2 = sp[2], s3 = sp[3];
    const float qa = ((s0[0] + s0[1]) + (s0[2] + s0[3])) + ((s1[0] + s1[1]) + (s1[2] + s1[3])), qb = ((s2[0] + s2[1]) + (s2[2] + s2[3])) + ((s3[0] + s3[1]) + (s3[2] + s3[3]));
    const float ra = 1.0f / sqrtf(qa * (1.f / 512.f) + EPS), rb = 1.0f / sqrtf(qb * (1.f / 512.f) + EPS);
    f32x4 acc[2] = {(f32x4){0.f, 0.f, 0.f, 0.f}, (f32x4){0.f, 0.f, 0.f, 0.f}};
    const bf16* ar = O + (size_t)(MP + row) * 1024 + 8 * fq; const bf16* b0 = Wout_t + (size_t)(32 * j + fr) * 1024 + 8 * fq; const bf16* b1 = b0 + 16 * 1024;
    skinny_k(ar, b0, b1, 16, acc[0], acc[1]);
    const float rr = ra / rb; acc[0] = acc[0] * rr; acc[1] = acc[1] * rr;
    skinny_k(ar + 512, b0 + 512, b1 + 512, 16, acc[0], acc[1]);
#pragma unroll
    for (int f = 0; f < 2; ++f) *(f32x4*)(MIXS + (size_t)row * 1024 + 32 * j + 16 * f + 4 * fq) = acc[f] * rb;
}
__device__ __forceinline__ void s4_slab(int j, const bf16* XN2, const bf16* Wgu_t, bf16* H) {
    SK_TID();
    const int g0 = 256 * ((16 * j) >> 7) + ((16 * j) & 127);
    f32x4 acc[2] = {(f32x4){0.f, 0.f, 0.f, 0.f}, (f32x4){0.f, 0.f, 0.f, 0.f}};
    skinny_k(XN2 + (size_t)(MP + row) * 1024 + 8 * fq, Wgu_t + (size_t)(g0 + fr) * 1024 + 8 * fq, Wgu_t + (size_t)(g0 + 128 + fr) * 1024 + 8 * fq, 32, acc[0], acc[1]);
    float hv[4];
#pragma unroll
    for (int e = 0; e < 4; ++e) { const float g = acc[0][e], up = acc[1][e]; hv[e] = g * up * __builtin_amdgcn_rcpf(1.0f + __builtin_amdgcn_exp2f(-g * LOG2E)); }
    *(unsigned long long*)(H + (size_t)(MP + row) * DFF + 16 * j + 4 * fq) = (unsigned long long)pk2(hv[0], hv[1]) | ((unsigned long long)pk2(hv[2], hv[3]) << 32);
}
__device__ __forceinline__ void s5_slab(int j, const bf16* H, const bf16* Wdn_t, float* FFS) {
    SK_TID();
    f32x4 acc[2] = {(f32x4){0.f, 0.f, 0.f, 0.f}, (f32x4){0.f, 0.f, 0.f, 0.f}};
    skinny_k(H + (size_t)(MP + row) * DFF + 8 * fq, Wdn_t + (size_t)(32 * j + fr) * DFF + 8 * fq, Wdn_t + (size_t)(32 * j + 16 + fr) * DFF + 8 * fq, DFF / 32, acc[0], acc[1]);
#pragma unroll
    for (int f = 0; f < 2; ++f) *(f32x4*)(FFS + (size_t)row * 1024 + 32 * j + 16 * f + 4 * fq) = acc[f];
}

__global__ void __launch_bounds__(NWAVES * 64, 2) fwd_megakernel(Args a) {
    extern __shared__ __attribute__((aligned(16))) unsigned char lds_raw[];
    cg::grid_group grid = cg::this_grid();
    LAS unsigned char* lds = (LAS unsigned char*)lds_raw;
#define FRESH_TID() int tid_ = threadIdx.x; asm volatile("" : "+v"(tid_)); const int tid = tid_, lane = tid & 63, wave = __builtin_amdgcn_readfirstlane(tid >> 6); const int gw = vcu * NWAVES + wave; (void)lane; (void)gw
    const int G = gridDim.x, bx = blockIdx.x;
    const int vcu = (G % 8 == 0) ? (bx % 8) * (G / 8) + bx / 8 : bx;
    unsigned char* ws = a.ws;
    const float* xp = a.in[0]; const float* xs = a.in[1];
    bf16* Win_t = (bf16*)(ws + WS_WIN); bf16* Wout_t = (bf16*)(ws + WS_WOUT); bf16* Wgu_t = (bf16*)(ws + WS_WGU); bf16* Wdn_t = (bf16*)(ws + WS_WDN);
    bf16* XN = (bf16*)(ws + WS_XN); bf16* XN2 = (bf16*)(ws + WS_XN2); bf16* QKV = (bf16*)(ws + WS_QKV); bf16* HB = (bf16*)(ws + WS_QKV);
    float* MIX = (float*)(ws + WS_QKV); float* FF = (float*)(ws + WS_FF); float* SSQ = (float*)(ws + WS_SSQ);
    float* CBP = (float*)(ws + WS_CBP); float* CBS = (float*)(ws + WS_CBS); float* TAB = (float*)(ws + WS_TAB);
    float* Y = a.out + O_Y; float* MIXS = (float*)(ws + WS_MIXS); unsigned* ctl = (unsigned*)(ws + WS_CTL); LAS unsigned* lflag = (LAS unsigned*)(lds + TAB_OFF + 2048);
    const int NGW = G * NWAVES;

#if PH & 1
    {
        FRESH_TID();
        LAS float* scr = (LAS float*)(lds + wave * 16384);
        constexpr int I_IN = 16 * 96, I_OUT = 16 * 32, I_G = 16 * 88, I_D = 44 * 32, NITEMS = I_IN + I_OUT + 2 * I_G + I_D;
        for (int it = gw; it < NITEMS; it += NGW) {
            int r = it;
            if (r < I_IN) { const int kb = r / 96, nb = r % 96, n0 = nb * 32, sc0 = n0 < 1536 ? n0 : n0 + 8;
                p0_transpose_item(a.in[8] + (size_t)(kb * 64) * DIN + sc0, DIN, Win_t + (size_t)n0 * 1024 + kb * 64, 1024, nullptr, scr, lane); continue; } r -= I_IN;
            if (r < I_OUT) { const int kb = r / 32, nb = r % 32, k0 = kb * 64; const float* ks = (k0 < 512 ? a.in[11] + k0 : a.in[12] + (k0 - 512));
                p0_transpose_item(a.in[13] + (size_t)k0 * 1024 + nb * 32, 1024, Wout_t + (size_t)(nb * 32) * 1024 + k0, 1024, ks, scr, lane); continue; } r -= I_OUT;
            if (r < 2 * I_G) { const int up = r >= I_G; if (up) r -= I_G; const int kb = r / 88, nb = r % 88, n0 = nb * 32, drow = 256 * (n0 / 128) + (up ? 128 : 0) + (n0 % 128);
                p0_transpose_item((up ? a.in[17] : a.in[16]) + (size_t)(kb * 64) * DFF + n0, DFF, Wgu_t + (size_t)drow * 1024 + kb * 64, 1024, nullptr, scr, lane); continue; } r -= 2 * I_G;
            { const int kb = r / 32, nb = r % 32;
                p0_transpose_item(a.in[18] + (size_t)(kb * 64) * 1024 + nb * 32, 1024, Wdn_t + (size_t)(nb * 32) * DFF + kb * 64, DFF, nullptr, scr, lane); }
        }
        {
            float wf[16][8];
#pragma unroll
            for (int j = 0; j < 4; ++j)
#pragma unroll
                for (int e = 0; e < 4; ++e) { const int k = 256 * j + 4 * lane + e; const f32x4* p = (const f32x4*)(a.in[8] + (size_t)k * DIN + 1536); const f32x4 u0 = p[0], u1 = p[1];
                    wf[4 * j + e][0] = u0[0]; wf[4 * j + e][1] = u0[1]; wf[4 * j + e][2] = u0[2]; wf[4 * j + e][3] = u0[3]; wf[4 * j + e][4] = u1[0]; wf[4 * j + e][5] = u1[1]; wf[4 * j + e][6] = u1[2]; wf[4 * j + e][7] = u1[3]; }
            f32x4 gv[4];
#pragma unroll
            for (int j = 0; j < 4; ++j) gv[j] = ((const f32x4*)a.in[7])[64 * j + lane];
            const float bfv = a.in[9][lane & 7];
            for (int m = gw; m < MTOT; m += NGW) {
                const f32x4* xr = (const f32x4*)(m < MP ? xp + (size_t)m * 1024 : xs + (size_t)(m - MP) * 1024) + lane;
                f32x4 v[4]; float ss = 0.f;
#pragma unroll
                for (int j = 0; j < 4; ++j) { v[j] = xr[64 * j]; ss += (v[j][0] * v[j][0] + v[j][1] * v[j][1]) + (v[j][2] * v[j][2] + v[j][3] * v[j][3]); }
                const float rstd = 1.0f / sqrtf(wave_sum(ss) * (1.f / 1024.f) + EPS);
                float z[8];
#pragma unroll
                for (int c = 0; c < 8; ++c) z[c] = 0.f;
                unsigned long long* o8 = (unsigned long long*)(XN + (size_t)m * 1024) + lane;
#pragma unroll
                for (int j = 0; j < 4; ++j) { v[j] = v[j] * rstd * gv[j];
                    o8[64 * j] = (unsigned long long)pk2(v[j][0], v[j][1]) | ((unsigned long long)pk2(v[j][2], v[j][3]) << 32);
#pragma unroll
                    for (int e = 0; e < 4; ++e)
#pragma unroll
                        for (int c = 0; c < 8; ++c) z[c] += v[j][e] * wf[4 * j + e][c]; }
#pragma unroll
                for (int c = 0; c < 8; ++c) z[c] = wave_sum(z[c]);
                float zz = z[0];
#pragma unroll
                for (int c = 1; c < 8; ++c) zz = (lane == c) ? z[c] : zz;
                if (lane < 8) { const float t = zz + bfv; const float lf = fminf(t, 0.f) - log1pf(expf(-fabsf(t)));
                    if (m < MP) a.out[O_LFP + (size_t)m * 8 + lane] = lf; else a.out[O_LFS + (size_t)(m - MP) * 8 + lane] = lf; }
            }
        }
        if (bx == 0 && tid < 2) ctl[64 * tid] = 0u;
        for (int i = bx * 512 + tid; i < (MPAD - MTOT) * 1024 * 2 / 16; i += G * 512) ((v4u*)(XN + (size_t)MTOT * 1024))[i] = (v4u){0u, 0u, 0u, 0u};
    }
#endif
    grid.sync();

#if PH & 2
    {
        FRESH_TID();
        if (bx < 192) {
            const bool smp = bx >= 128; const int bb = smp ? (bx - 128) >> 3 : bx >> 3, h = bx & 7; const int n = smp ? PAST + STOK : SEQ;
            float v[4];
#pragma unroll
            for (int e = 0; e < 4; ++e) { const int i = 4 * tid + e; float x = 0.f;
                if (i < n) { if (!smp) x = a.out[O_LFP + ((size_t)bb * SEQ + i) * 8 + h]; else x = i < PAST ? a.in[4][((size_t)bb * PAST + i) * 8 + h] : a.out[O_LFS + ((size_t)bb * STOK + (i - PAST)) * 8 + h]; }
                v[e] = x; }
            v[1] += v[0]; v[2] += v[1]; v[3] += v[2];
            const float tot = v[3]; float sc = tot;
#pragma unroll
            for (int o = 1; o < 64; o <<= 1) { const float t = __shfl_up(sc, o); if (lane >= o) sc += t; }
            LAS float* wt = (LAS float*)lds;
            if (lane == 63) wt[wave] = sc;
            __syncthreads();
            float base = sc - tot;
            for (int w = 0; w < wave; ++w) base += wt[w];
            float* dst = smp ? CBS + (size_t)(bb * 8 + h) * 1040 : CBP + (size_t)(bb * 8 + h) * SEQ;
#pragma unroll
            for (int e = 0; e < 4; ++e) { const int i = 4 * tid + e; if (i < n) dst[i] = -(base + v[e]) * LOG2E; }
        } else if (bx == 192) {
            for (int idx = tid; idx < 8 * 2048; idx += 512) { const int h = idx >> 11, i = idx & 2047; TAB[idx] = i < 256 ? (a.in[10][h * 257 + i] - a.in[10][h * 257 + 256]) * LOG2E : 0.f; }
        }
        __syncthreads();
        pg8::Gemm g{XN, Win_t, MP, NQKV, 1024}; pg8::StaticOrder S; S.init(MP, NQKV, G, bx);
        pg8::EpiQKV E{QKV, a.out};
        pg8::gemm_phase<pg8::EpiQKV, pg8::StaticOrder, true, true>(lds, g, S, E);
        for (int j = G - 1 - bx; j < NQKV / 32; j += G) s1_slab(j, XN, Win_t, QKV, a.out);
    }
#endif
    grid.sync();

#if PH & 4
    {
        FRESH_TID();
        using abf = attn_body::bf16;
        const abf* Qb = (const abf*)QKV; abf* Ob = (abf*)XN;
        for (int v = vcu; v < 256; v += G) {
            const int pr = v >> 1, half = v & 1, b = pr >> 3, h = pr & 7;
            const float* cbg = CBP + (size_t)(b * 8 + h) * SEQ; const float* tbg = TAB + h * 2048;
            const unsigned long long sched = half ? 0x89FE12345ull : 0xDCBA067ull;
            const int nun = half ? 9 : 7;
            for (int i = 0; i < nun; ++i) { const int e = (int)((sched >> (4 * i)) & 15ull), qb = e & 7;
                if (e < 8) {
#if AM & 1
                    attn_body::attn_unit<0, 8>(b, h, qb, Qb, Qb + 512, Qb + 1024, Ob, SSQ, h, cbg, (char*)lds_raw);
#endif
                } else {
#if AM & 2
                    attn_body::attn_unit<1, 8>(b, h, qb, Qb + 1536, Qb + 2048, Qb + 2560, Ob + 512, SSQ, 8 + h, tbg, (char*)lds_raw);
#endif
                }
            }
#if AM & 4
            if (half == 0 && pr < 128) sample_attn_item(a, ws, lds, pr);
#endif
        }
    }
#endif
    grid.sync();

#if PH & 8
    {
        FRESH_TID();
        pg8::Gemm g{XN, Wout_t, MP, 1024, 1024}; pg8::StaticOrder S; S.init(MP, 1024, G, bx);
        LAS float* tab = (LAS float*)(lds + TAB_OFF);
        pg8::Unit u;
        for (int i = 0; S.next(i, u); ++i) {
            if (tid < 256) { const f32x4* sp = (const f32x4*)(SSQ + (size_t)(u.pm * 256 + tid) * 16); const f32x4 s0 = sp[0], s1 = sp[1], s2 = sp[2], s3 = sp[3];
                const float qa = ((s0[0] + s0[1]) + (s0[2] + s0[3])) + ((s1[0] + s1[1]) + (s1[2] + s1[3])), qb = ((s2[0] + s2[1]) + (s2[2] + s2[3])) + ((s3[0] + s3[1]) + (s3[2] + s3[3]));
                const float ra = 1.0f / sqrtf(fabsf(qa) * (1.f / 512.f) + EPS), rb = 1.0f / sqrtf(fabsf(qb) * (1.f / 512.f) + EPS);
                tab[2 * tid] = ra / rb; tab[2 * tid + 1] = rb; }
            __syncthreads();
            pg8::EpiF32<true> E{MIX, 1024, tab};
            pg8::gemm_phase<pg8::EpiF32<true>, pg8::OneUnit, false, true>(lds, g, pg8::OneUnit{u}, E);
            __syncthreads();
        }
        for (int j = G - 1 - bx; j < 32; j += G) {
            s3_slab(j, XN, Wout_t, SSQ, MIXS);
            if (last_arriver(ctl, 32u, lflag, tid)) {
                f32x4 g1[4], g2[4];
#pragma unroll
                for (int q = 0; q < 4; ++q) { g1[q] = ((const f32x4*)a.in[14])[64 * q + lane]; g2[q] = ((const f32x4*)a.in[15])[64 * q + lane]; }
                for (int r = 16 * wave; r < 16 * wave + 16; ++r) rowpass_mix(MIXS + (size_t)r * 1024, xs + (size_t)r * 1024, Y + (size_t)(MP + r) * 1024, XN2 + (size_t)(MP + r) * 1024, g1, g2, lane);
            }
        }
    }
#endif
    grid.sync();

#if PH & 16
    {
        FRESH_TID();
        f32x4 g1[4], g2[4];
#pragma unroll
        for (int j = 0; j < 4; ++j) { g1[j] = ((const f32x4*)a.in[14])[64 * j + lane]; g2[j] = ((const f32x4*)a.in[15])[64 * j + lane]; }
        for (int m = gw; m < MP; m += NGW) rowpass_mix(MIX + (size_t)m * 1024, xp + (size_t)m * 1024, Y + (size_t)m * 1024, XN2 + (size_t)m * 1024, g1, g2, lane);
    }
#endif
    grid.sync();

#if PH & 32
    {
        FRESH_TID();
        pg8::Gemm g{XN2, Wgu_t, MP, NGU, 1024}; pg8::StaticOrder S; S.init(MP, NGU, G, bx);
        pg8::EpiSwiGLU E{HB};
        pg8::gemm_phase<pg8::EpiSwiGLU, pg8::StaticOrder, true, true>(lds, g, S, E);
        for (int j = G - 1 - bx; j < DFF / 16; j += G) s4_slab(j, XN2, Wgu_t, HB);
    }
#endif
    grid.sync();

#if PH & 64
    {
        FRESH_TID();
        pg8::Gemm g{HB, Wdn_t, MP, 1024, DFF}; pg8::StaticOrder S; S.init(MP, 1024, G, bx);
        pg8::EpiF32<false> E{FF, 1024, nullptr};
        pg8::gemm_phase<pg8::EpiF32<false>, pg8::StaticOrder, true, true>(lds, g, S, E);
        for (int j = G - 1 - bx; j < 32; j += G) {
            s5_slab(j, HB, Wdn_t, MIXS);
            if (last_arriver(ctl + 64, 32u, lflag, tid)) {
                f32x4 g3[4];
#pragma unroll
                for (int q = 0; q < 4; ++q) g3[q] = ((const f32x4*)a.in[19])[64 * q + lane];
                for (int r = 16 * wave; r < 16 * wave + 16; ++r) rowpass_ff(MIXS + (size_t)r * 1024, Y + (size_t)(MP + r) * 1024, g3, lane);
            }
        }
    }
#endif
    grid.sync();

#if PH & 128
    {
        FRESH_TID();
        f32x4 g3[4];
#pragma unroll
        for (int j = 0; j < 4; ++j) g3[j] = ((const f32x4*)a.in[19])[64 * j + lane];
        for (int m = gw; m < MP; m += NGW) rowpass_ff(FF + (size_t)m * 1024, Y + (size_t)m * 1024, g3, lane);
    }
#endif
}

extern "C" void kernel_launch(void* const* d_in, const int* in_sizes, int n_in, void* d_out, int out_size, void* d_ws, size_t ws_size, hipStream_t stream) {
    static int grid = 0;
    if (grid == 0) {
        if (n_in != 20 || out_size != (int)O_END || ws_size < WS_END) { fprintf(stderr, "kernel_launch: unexpected shapes (n_in %d, out %d, ws %zu)\n", n_in, out_size, ws_size); grid = -1; return; }
        int dev = 0, cus = 0, per_cu = 0;
        hipGetDevice(&dev); hipDeviceGetAttribute(&cus, hipDeviceAttributeMultiprocessorCount, dev);
        hipFuncSetAttribute((const void*)fwd_megakernel, hipFuncAttributeMaxDynamicSharedMemorySize, LDS_BYTES);
        hipOccupancyMaxActiveBlocksPerMultiprocessor(&per_cu, (const void*)fwd_megakernel, NWAVES * 64, LDS_BYTES);
        (void)hipGetLastError();
        if (per_cu < 1) { fprintf(stderr, "kernel_launch: occupancy query says %d blocks/CU\n", per_cu); per_cu = 1; }
        grid = cus;
    }
    if (grid < 0) return;
    Args a{};
    for (int i = 0; i < 20; ++i) a.in[i] = (const float*)d_in[i];
    a.out = (float*)d_out; a.ws = (unsigned char*)d_ws;
    void* args[] = {&a};
    hipError_t e = hipLaunchCooperativeKernel((const void*)fwd_megakernel, dim3(grid), dim3(NWAVES * 64), args, LDS_BYTES, stream);
    if (e != hipSuccess) fprintf(stderr, "cooperative launch failed: %s (grid %d)\n", hipGetErrorString(e), grid);
}
```

```cpp
#include <hip/hip_runtime.h>
#include <hip/hip_cooperative_groups.h>
#include <hip/hip_bf16.h>
#include <cstdio>
#include <cstdint>
#include <cmath>
namespace cg = cooperative_groups;

constexpr int DMODEL = 1024, NB = 16, SEQ = 2048, MP = NB * SEQ  , SBATCH = 8, STOK = 16, MS = SBATCH * STOK  ;
constexpr int MTOT = MP + MS  , MPAD = 33024  , PAST = 1024, BLEN = 512;
constexpr int DFF = 2816, DIN = 3080, NQKV = 3072, NGU = 2 * DFF;
constexpr float EPS = 1e-6f, LOG2E = 1.4426950408889634f;
constexpr float C2 = 0.125f * 1.4426950408889634f;
constexpr size_t O_Y = 0, O_AKP = 33685504, O_AVP = 50462720, O_LFP = 67239936, O_BKP = 67502080, O_BVP = 71696384,
                 O_AKS = 75890688, O_AVS = 75956224, O_LFS = 76021760, O_BKS = 76022784, O_BVS = 76088320, O_END = 76153856;
namespace pg8 {
#define PG8_LAS __attribute__((address_space(3)))
typedef unsigned short bf16_t;
typedef short bf16x8 __attribute__((ext_vector_type(8)));
typedef float f32x4 __attribute__((ext_vector_type(4)));
typedef unsigned u32x4 __attribute__((ext_vector_type(4)));
constexpr int BM = 256, BK = 64, HALF = 128, HTB = HALF * BK * 2  , STAGE_BYTES = 8 * HTB, NXCD = 8, WGM = 8;

__host__ __device__ __forceinline__ int lds_byte(int r, int c) { const int st = (r >> 4) * 2 + (c >> 5), rr = r & 15, cc = c & 31, ob = rr * 64 + cc * 2; return st * 1024 + (ob ^ (((ob >> 9) & 1) << 5)); }
__host__ __device__ __forceinline__ void stage_rc(int b, int& R, int& C) { const int st = b / 1024, sb = b % 1024, swz = sb ^ (((sb >> 9) & 1) << 5); R = (st >> 1) * 16 + swz / 64; C = (st & 1) * 32 + (swz % 64) / 2; }
__host__ __device__ __forceinline__ int perm32(int rho) { const int n = rho >> 4, i = rho & 15; return 8 * (i >> 2) + 4 * n + (i & 3); }

struct Unit { int pm, pn; };
struct Gemm { const bf16_t* A; const bf16_t* Bt; int M, N, K; };

struct StaticOrder {
    int nM, nN, nwg, G, c;
    __host__ __device__ void init(int M, int N, int G_, int c_) { nM = M / BM; nN = N / BM; nwg = nM * nN; G = G_; c = c_; }
    __host__ __device__ bool next(int i, Unit& u) const {
        const long L = (long)i * G + c; if (L >= nwg) return false;
        int wgid = (int)L; { const int q = nwg / NXCD, r = nwg % NXCD, xcd = wgid % NXCD, off = wgid / NXCD; wgid = (xcd < r ? xcd * (q + 1) : r * (q + 1) + (xcd - r) * q) + off; }
        const int nig = WGM * nN, gid = wgid / nig, fm = gid * WGM, gsz = (nM - fm) < WGM ? (nM - fm) : WGM;
        u.pm = fm + ((wgid % nig) % gsz); u.pn = (wgid % nig) / gsz; return true;
    }
    __device__ __forceinline__ void a_ready(const Unit&) const {}
    __device__ __forceinline__ void done(const Unit&) const {}
};

__device__ __forceinline__ unsigned cvt_pk_bf16(float lo, float hi) { unsigned r; asm volatile("v_cvt_pk_bf16_f32 %0, %1, %2" : "=v"(r) : "v"(lo), "v"(hi)); return r; }
struct OneUnit {
    Unit u;
    __device__ __forceinline__ bool next(int i, Unit& o) const { if (i) return false; o = u; return true; }
    __device__ __forceinline__ void a_ready(const Unit&) const {}
    __device__ __forceinline__ void done(const Unit&) const {}
};
typedef float f32x2 __attribute__((ext_vector_type(2)));
struct EpiQKV {
    static constexpr bool PERM = true, AFTER_DRAIN = false, HAS_MID = false; static constexpr int MID_T = -1;
    bf16_t* QKV; float* out;
    __device__ __forceinline__ void mid(f32x4 (&)[2][2][4][2], int, int) const {}
    __device__ __forceinline__ void operator()(const f32x4 (&acc)[2][2][4][2], const Unit& u, int wr, int wc, int fr, int fq) const {
        const int type = u.pn >> 1, colt = (u.pn & 1) * 256 + wc * 32 + 8 * fq;
        const float sc = (type == 0 || type == 3) ? C2 : 1.f;
        const bool sample = (u.pm == MP / 256);
        float* fb = nullptr;
        if (type == 1 || type == 2 || type == 4 || type == 5) {
            if (sample) fb = out + (type == 1 ? O_AKS : type == 2 ? O_AVS : type == 4 ? O_BKS : O_BVS);
            else if (type < 3) fb = out + (type == 1 ? O_AKP : O_AVP) + (size_t)u.pm * 256 * 512;
            else { const int bt = u.pm & 7; if (bt >= 6) fb = out + (type == 4 ? O_BKP : O_BVP) + ((size_t)(u.pm >> 3) * 512 + (size_t)(bt - 6) * 256) * 512; }
        }
#pragma unroll
        for (int ai = 0; ai < 2; ++ai) {
            if (sample && ai == 1) break;
#pragma unroll
            for (int m = 0; m < 4; ++m) { const int rl = ai * HALF + wr * 64 + m * 16 + fr;
                bf16_t* rowp = QKV + (size_t)(u.pm * BM + rl) * NQKV + u.pn * BM + wc * 32 + 8 * fq;
#pragma unroll
                for (int bj = 0; bj < 2; ++bj) { f32x4 v0 = acc[ai][bj][m][0], v1 = acc[ai][bj][m][1];
                    if (fb) { float* fp = fb + (size_t)rl * 512 + colt + bj * HALF; *(f32x4*)fp = v0; *(f32x4*)(fp + 4) = v1; }
                    v0 = v0 * sc; v1 = v1 * sc; u32x4 w; w.x = cvt_pk_bf16(v0[0], v0[1]); w.y = cvt_pk_bf16(v0[2], v0[3]); w.z = cvt_pk_bf16(v1[0], v1[1]); w.w = cvt_pk_bf16(v1[2], v1[3]);
                    *(u32x4*)(rowp + bj * HALF) = w; } }
        }
    }
};
struct EpiSwiGLU {
    static constexpr bool PERM = true, AFTER_DRAIN = false, HAS_MID = false; static constexpr int MID_T = -1;
    bf16_t* H;
    __device__ __forceinline__ void mid(f32x4 (&)[2][2][4][2], int, int) const {}
    __device__ __forceinline__ void operator()(const f32x4 (&acc)[2][2][4][2], const Unit& u, int wr, int wc, int fr, int fq) const {
#pragma unroll
        for (int ai = 0; ai < 2; ++ai)
#pragma unroll
            for (int m = 0; m < 4; ++m) { const int row = u.pm * BM + ai * HALF + wr * 64 + m * 16 + fr;
                float hv[8];
#pragma unroll
                for (int n = 0; n < 2; ++n)
#pragma unroll
                    for (int e = 0; e < 4; ++e) { const float g = acc[ai][0][m][n][e], up = acc[ai][1][m][n][e];
                        hv[4 * n + e] = g * up * __builtin_amdgcn_rcpf(1.0f + __builtin_amdgcn_exp2f(-g * LOG2E)); }
                u32x4 w; w.x = cvt_pk_bf16(hv[0], hv[1]); w.y = cvt_pk_bf16(hv[2], hv[3]); w.z = cvt_pk_bf16(hv[4], hv[5]); w.w = cvt_pk_bf16(hv[6], hv[7]);
                *(u32x4*)(H + (size_t)row * DFF + u.pn * HALF + wc * 32 + 8 * fq) = w; }
    }
};
template <bool MID> struct EpiF32 {
    static constexpr bool PERM = false, AFTER_DRAIN = false, HAS_MID = MID; static constexpr int MID_T = 8;
    float* F; int ldc; const PG8_LAS float* tab;
    __device__ __forceinline__ void mid(f32x4 (&acc)[2][2][4][2], int wr, int fr) const {
#pragma unroll
        for (int ai = 0; ai < 2; ++ai)
#pragma unroll
            for (int m = 0; m < 4; ++m) { const float s = tab[(ai * HALF + wr * 64 + m * 16 + fr) * 2];
#pragma unroll
                for (int bj = 0; bj < 2; ++bj)
#pragma unroll
                    for (int n = 0; n < 2; ++n) acc[ai][bj][m][n] = acc[ai][bj][m][n] * s; }
    }
    __device__ __forceinline__ void operator()(const f32x4 (&acc)[2][2][4][2], const Unit& u, int wr, int wc, int fr, int fq) const {
        const int col0 = u.pn * BM + wc * 32 + 4 * fq;
#pragma unroll
        for (int ai = 0; ai < 2; ++ai)
#pragma unroll
            for (int m = 0; m < 4; ++m) { const int rl = ai * HALF + wr * 64 + m * 16 + fr; const float s = MID ? tab[rl * 2 + 1] : 1.f;
                float* rowp = F + (size_t)(u.pm * BM + rl) * ldc + col0;
#pragma unroll
                for (int bj = 0; bj < 2; ++bj)
#pragma unroll
                    for (int n = 0; n < 2; ++n) *(f32x4*)(rowp + bj * HALF + n * 16) = acc[ai][bj][m][n] * s; }
    }
};

template <class Epi, class Sched, bool ALIGN_EPI = false, bool SP2 = false>
__device__ __forceinline__ void gemm_phase(PG8_LAS unsigned char* lds, const Gemm g, const Sched& S, const Epi& E) {
    int tid_ = threadIdx.x; asm volatile("" : "+v"(tid_));
    const int tid = tid_, wid = __builtin_amdgcn_readfirstlane(tid >> 6), lane = tid & 63, wr = wid >> 2, wc = wid & 3, fr = lane & 15, fq = lane >> 4;
    const int K = g.K, nt = K / BK;
    unsigned voffA[2], voffB[2];
#pragma unroll
    for (int i = 0; i < 2; ++i) { int R, C; stage_rc(tid * 16 + i * 8192, R, C); const int Rb = Epi::PERM ? ((R & ~31) + perm32(R & 31)) : R;
        voffA[i] = (unsigned)(R * K + C) * 2u; voffB[i] = (unsigned)(Rb * K + C) * 2u; }
    const size_t kstep = (size_t)(BK * 2);
    const size_t hstep = (size_t)HALF * K * 2;
    const size_t tstep = 2 * hstep;
    const unsigned ldsw = (unsigned)wid * 1024u;
    const int aoff = lds_byte(wr * 64 + fr, fq * 8), boff = lds_byte(wc * 32 + fr, fq * 8);
#define PG8_SA(b, h) (((b) * 2 + (h)) * HTB)
#define PG8_SB(b, h) ((4 + (b) * 2 + (h)) * HTB)
#define PG8_STAGE(bufoff, gbase, voff) do { _Pragma("unroll") for (int _i = 0; _i < 2; ++_i) \
        __builtin_amdgcn_global_load_lds((const unsigned*)((const char*)(gbase) + (voff)[_i]), (PG8_LAS unsigned*)(lds + (bufoff) + ldsw + _i * 8192), 16, 0, 0); } while (0)
#define PG8_LDA(dst, b, h) do { _Pragma("unroll") for (int m = 0; m < 4; ++m) _Pragma("unroll") for (int k = 0; k < 2; ++k) dst[m][k] = *(const PG8_LAS bf16x8*)(lds + PG8_SA(b, h) + aoff + m * 2048 + k * 1024); } while (0)
#define PG8_LDB(dst, b, h) do { _Pragma("unroll") for (int n = 0; n < 2; ++n) _Pragma("unroll") for (int k = 0; k < 2; ++k) dst[n][k] = *(const PG8_LAS bf16x8*)(lds + PG8_SB(b, h) + boff + n * 2048 + k * 1024); } while (0)
#define PG8_MMA(ai, bj, At, Bt) do { __builtin_amdgcn_s_setprio(1); _Pragma("unroll") for (int m = 0; m < 4; ++m) _Pragma("unroll") for (int n = 0; n < 2; ++n) _Pragma("unroll") for (int k = 0; k < 2; ++k) \
        acc[ai][bj][m][n] = __builtin_amdgcn_mfma_f32_16x16x32_bf16(Bt[n][k], At[m][k], acc[ai][bj][m][n], 0, 0, 0); __builtin_amdgcn_s_setprio(0); } while (0)
#define PG8_WAIT_V(n) asm volatile("s_waitcnt vmcnt(" #n ")" ::: "memory")
#define PG8_WAIT_L(n) asm volatile("s_waitcnt lgkmcnt(" #n ")" ::: "memory")
#define PG8_BAR __builtin_amdgcn_s_barrier()
#define PG8_SCHED __builtin_amdgcn_sched_barrier(0)
    Unit cur, nxt; int ui = 0;
    if (!S.next(0, cur)) return;
    f32x4 acc[2][2][4][2];
#pragma unroll
    for (int a = 0; a < 2; ++a)
#pragma unroll
        for (int b = 0; b < 2; ++b)
#pragma unroll
            for (int m = 0; m < 4; ++m)
#pragma unroll
                for (int n = 0; n < 2; ++n) acc[a][b][m][n] = (f32x4){0.f, 0.f, 0.f, 0.f};
    bf16x8 At[4][2], B0[2][2], B1[2][2];
    const char* cA = (const char*)g.A + (size_t)cur.pm * tstep; const char* cB = (const char*)g.Bt + (size_t)cur.pn * tstep;
    S.a_ready(cur);
    if constexpr (SP2) {
        PG8_STAGE(PG8_SB(0, 0), cB, voffB); PG8_STAGE(PG8_SB(0, 1), cB + hstep, voffB); PG8_STAGE(PG8_SA(0, 0), cA, voffA); PG8_STAGE(PG8_SA(0, 1), cA + hstep, voffA);
        if (wr == 1) PG8_BAR;
        PG8_WAIT_V(2); PG8_BAR;
        PG8_STAGE(PG8_SB(1, 0), cB + kstep, voffB); PG8_STAGE(PG8_SA(1, 0), cA + kstep, voffA); PG8_STAGE(PG8_SB(1, 1), cB + hstep + kstep, voffB);
        PG8_WAIT_V(6); PG8_BAR;
    } else {
        PG8_STAGE(PG8_SB(0, 0), cB, voffB); PG8_STAGE(PG8_SA(0, 0), cA, voffA); PG8_STAGE(PG8_SB(0, 1), cB + hstep, voffB); PG8_STAGE(PG8_SA(0, 1), cA + hstep, voffA);
        if (wr == 1) PG8_BAR;
        PG8_WAIT_V(4); PG8_BAR;
        PG8_STAGE(PG8_SB(1, 0), cB + kstep, voffB); PG8_STAGE(PG8_SA(1, 0), cA + kstep, voffA); PG8_STAGE(PG8_SB(1, 1), cB + hstep + kstep, voffB);
        PG8_WAIT_V(6); PG8_BAR;
    }
    for (;;) {
        const bool has_next = S.next(ui + 1, nxt);
        const char* nA = has_next ? (const char*)g.A + (size_t)nxt.pm * tstep : cA; const char* nB = has_next ? (const char*)g.Bt + (size_t)nxt.pn * tstep : cB;
        for (int t = 0; t < nt; t += 2) {
            const bool last = (t == nt - 2);
            if constexpr (Epi::HAS_MID) { if (t == Epi::MID_T) E.mid(acc, wr, fr); }
            const char* a1 = cA + (size_t)(t + 1) * kstep;
            const char* a2 = last ? nA : cA + (size_t)(t + 2) * kstep; const char* b2 = last ? nB : cB + (size_t)(t + 2) * kstep;
            const char* a3 = a2 + kstep; const char* b3 = b2 + kstep;
            if (last && has_next) S.a_ready(nxt);
            if constexpr (SP2) {
            PG8_LDB(B0, 0, 0); PG8_LDB(B1, 0, 1); PG8_SCHED; PG8_LDA(At, 0, 0); PG8_STAGE(PG8_SA(1, 1), a1 + hstep, voffA);
            PG8_WAIT_V(8); PG8_WAIT_L(0); PG8_BAR; PG8_MMA(0, 0, At, B0); PG8_MMA(0, 1, At, B1); PG8_BAR; PG8_SCHED;
            PG8_LDA(At, 0, 1); PG8_STAGE(PG8_SB(0, 0), b2, voffB); PG8_STAGE(PG8_SB(0, 1), b2 + hstep, voffB); PG8_STAGE(PG8_SA(0, 0), a2, voffA);
            PG8_WAIT_V(8); PG8_WAIT_L(0); PG8_BAR; PG8_MMA(1, 0, At, B0); PG8_MMA(1, 1, At, B1); PG8_BAR; PG8_SCHED;
            PG8_LDB(B0, 1, 0); PG8_LDB(B1, 1, 1); PG8_SCHED; PG8_LDA(At, 1, 0); PG8_STAGE(PG8_SA(0, 1), a2 + hstep, voffA);
            PG8_WAIT_V(8); PG8_WAIT_L(0); PG8_BAR; PG8_MMA(0, 0, At, B0); PG8_MMA(0, 1, At, B1); PG8_BAR; PG8_SCHED;
            PG8_LDA(At, 1, 1); PG8_STAGE(PG8_SB(1, 0), b3, voffB); PG8_STAGE(PG8_SB(1, 1), b3 + hstep, voffB); PG8_STAGE(PG8_SA(1, 0), a3, voffA);
            PG8_WAIT_V(8); PG8_WAIT_L(0); PG8_BAR; PG8_MMA(1, 0, At, B0); PG8_MMA(1, 1, At, B1); PG8_BAR; PG8_SCHED;
            } else {
            PG8_LDB(B0, 0, 0); PG8_SCHED; PG8_LDA(At, 0, 0); PG8_STAGE(PG8_SA(1, 1), a1 + hstep, voffA);
            PG8_WAIT_L(8); PG8_BAR; PG8_WAIT_L(0); PG8_MMA(0, 0, At, B0); PG8_BAR; PG8_SCHED;
            PG8_LDB(B1, 0, 1); PG8_STAGE(PG8_SB(0, 0), b2, voffB);
            PG8_BAR; PG8_WAIT_L(0); PG8_MMA(0, 1, At, B1); PG8_BAR;
            PG8_LDA(At, 0, 1); PG8_STAGE(PG8_SA(0, 0), a2, voffA);
            PG8_BAR; PG8_WAIT_L(0); PG8_MMA(1, 0, At, B0); PG8_BAR; PG8_SCHED;
            PG8_STAGE(PG8_SB(0, 1), b2 + hstep, voffB);
            PG8_WAIT_V(6); PG8_BAR; PG8_MMA(1, 1, At, B1); PG8_BAR;
            PG8_LDB(B0, 1, 0); PG8_SCHED; PG8_LDA(At, 1, 0); PG8_STAGE(PG8_SA(0, 1), a2 + hstep, voffA);
            PG8_WAIT_L(8); PG8_BAR; PG8_WAIT_L(0); PG8_MMA(0, 0, At, B0); PG8_BAR; PG8_SCHED;
            PG8_LDB(B1, 1, 1); PG8_STAGE(PG8_SB(1, 0), b3, voffB);
            PG8_BAR; PG8_WAIT_L(0); PG8_MMA(0, 1, At, B1); PG8_BAR;
            PG8_LDA(At, 1, 1); PG8_STAGE(PG8_SA(1, 0), a3, voffA);
            PG8_BAR; PG8_WAIT_L(0); PG8_MMA(1, 0, At, B0); PG8_BAR; PG8_SCHED;
            PG8_STAGE(PG8_SB(1, 1), b3 + hstep, voffB);
            PG8_WAIT_V(6); PG8_BAR; PG8_MMA(1, 1, At, B1); PG8_BAR;
            }
        }
        if constexpr (ALIGN_EPI) { if (wr == 0) PG8_BAR; }
        if constexpr (!Epi::AFTER_DRAIN) { E(acc, cur, wr, wc, fr, fq); S.done(cur); }
        if (!has_next) break;
#pragma unroll
        for (int a = 0; a < 2; ++a)
#pragma unroll
            for (int b = 0; b < 2; ++b)
#pragma unroll
                for (int m = 0; m < 4; ++m)
#pragma unroll
                    for (int n = 0; n < 2; ++n) acc[a][b][m][n] = (f32x4){0.f, 0.f, 0.f, 0.f};
        cur = nxt; cA = nA; cB = nB; ++ui;
        if constexpr (ALIGN_EPI) { if (wr == 1) PG8_BAR; }
    }
    PG8_WAIT_V(0);
    if constexpr (!ALIGN_EPI) { if (wr == 0) PG8_BAR; }
    PG8_BAR;
    if constexpr (Epi::AFTER_DRAIN) { E.fused(acc, cur, wr, wc, fr, fq, lds, wid, lane); S.done(cur); }
#undef PG8_SA
#undef PG8_SB
#undef PG8_STAGE
#undef PG8_LDA
#undef PG8_LDB
#undef PG8_MMA
#undef PG8_WAIT_V
#undef PG8_WAIT_L
#undef PG8_BAR
#undef PG8_SCHED
}
}
#include <hip/hip_bf16.h>
#include <cmath>
#ifndef NOPOST
#define NOPOST 0
#endif
#ifndef NOSSQ
#define NOSSQ 0
#endif
namespace attn_body {
using bf16=__hip_bfloat16;
using bf16x8=__attribute__((ext_vector_type(8)))short;
using s16x4=__attribute__((ext_vector_type(4)))short;
using f32x16=__attribute__((ext_vector_type(16)))float;
using u32x4=__attribute__((ext_vector_type(4)))unsigned;
constexpr int SEQ=2048,D=64,DM=3072,DMO=1024;
constexpr int NW=8,QBLK=32,QB=QBLK*NW,KVBLK=64,NQB=SEQ/QB;
constexpr int ATTN_PITCH=DM, ATTN_UNIT_ROWS=QB;
__device__ __forceinline__ int crow(int r,int hi){return (r&3)+8*(r>>2)+4*hi;}
#define SBAR() __builtin_amdgcn_sched_barrier(0)
__device__ __forceinline__ void cmask(f32x16&p0,f32x16&p1,int jb,int qrel,int hi){
  const float NEG=-INFINITY; int kb=64*jb+4*hi;
  #pragma unroll
  for(int r=0;r<16;++r){int kv=kb+(r&3)+8*(r>>2); if(kv>qrel)p0[r]=NEG; if(kv+32>qrel)p1[r]=NEG;}
}

constexpr int NSLOT=3, SLOTB=8192;
constexpr int LDS_K=0, LDS_V=NSLOT*SLOTB, LDS_WS=2*NSLOT*SLOTB, LDS_OST=LDS_WS+NW*64*4, LDS_BYTES=LDS_OST+NW*4096, LDS_CB=LDS_BYTES, LDS_TOTAL=LDS_CB+8192;
constexpr float C2=0.125f*1.4426950408889634f;
__device__ __forceinline__ void glds16(const void*gsrc,unsigned lds_dst){unsigned keep;
  asm volatile("s_mov_b32 %0, m0\n\ts_mov_b32 m0, %2\n\ts_nop 0\n\tglobal_load_lds_dwordx4 %1, off\n\ts_mov_b32 m0, %0":"=&s"(keep):"v"(gsrc),"s"(lds_dst):"memory");}
__device__ __forceinline__ float max3f(float a,float b,float c){float r;asm("v_max3_f32 %0, %1, %2, %3":"=v"(r):"v"(a),"v"(b),"v"(c));return r;}
__device__ __forceinline__ float max2f(float a,float b){float r;asm("v_max_f32_e32 %0, %1, %2":"=v"(r):"v"(a),"v"(b));return r;}
__device__ __forceinline__ float fadd_s(float a,float b){float r;asm("v_add_f32_e32 %0, %1, %2":"=v"(r):"v"(a),"v"(b));return r;}
__device__ __forceinline__ float fsub_s(float a,float b){float r;asm("v_sub_f32_e32 %0, %1, %2":"=v"(r):"v"(a),"v"(b));return r;}
typedef float f32x2_t __attribute__((ext_vector_type(2))); typedef __bf16 bf16x2_t __attribute__((ext_vector_type(2)));
__device__ __forceinline__ unsigned cvtpk_s(float lo,float hi){f32x2_t v={lo,hi};bf16x2_t b=__builtin_convertvector(v,bf16x2_t);return __builtin_bit_cast(unsigned,b);}
#define WAIT_BAR(N) asm volatile("s_waitcnt vmcnt(" #N ") lgkmcnt(0)\n\ts_barrier":::"memory")

__device__ __forceinline__ void qkt(f32x16&p0,f32x16&p1,const char*Kslot,const bf16x8*qr,const f32x16&negm,int r32,int hi){
  const char*kb=Kslot+hi*1024+r32*16;
  #pragma unroll
  for(int d0=0;d0<4;++d0){
    const bf16x8 b0=*reinterpret_cast<const bf16x8*>(kb+d0*2048);
    const bf16x8 b1=*reinterpret_cast<const bf16x8*>(kb+d0*2048+512);
    if(d0==0){p0=__builtin_amdgcn_mfma_f32_32x32x16_bf16(b0,qr[0],negm,0,0,0);p1=__builtin_amdgcn_mfma_f32_32x32x16_bf16(b1,qr[0],negm,0,0,0);}
    else{p0=__builtin_amdgcn_mfma_f32_32x32x16_bf16(b0,qr[d0],p0,0,0,0);p1=__builtin_amdgcn_mfma_f32_32x32x16_bf16(b1,qr[d0],p1,0,0,0);}}
}
typedef __attribute__((address_space(3))) const char* lds_cptr;
typedef short v4i16_t __attribute__((ext_vector_type(4)));
__device__ __forceinline__ void kload8(bf16x8*kf,lds_cptr kp){
  kf[0]=*(const __attribute__((address_space(3))) bf16x8*)(kp);      kf[1]=*(const __attribute__((address_space(3))) bf16x8*)(kp+512);
  kf[2]=*(const __attribute__((address_space(3))) bf16x8*)(kp+2048); kf[3]=*(const __attribute__((address_space(3))) bf16x8*)(kp+2560);
  kf[4]=*(const __attribute__((address_space(3))) bf16x8*)(kp+4096); kf[5]=*(const __attribute__((address_space(3))) bf16x8*)(kp+4608);
  kf[6]=*(const __attribute__((address_space(3))) bf16x8*)(kp+6144); kf[7]=*(const __attribute__((address_space(3))) bf16x8*)(kp+6656);
}
__device__ __forceinline__ void kload2(bf16x8*kf,lds_cptr kp,int j){ kf[2*j]=*(const __attribute__((address_space(3))) bf16x8*)(kp+j*2048); kf[2*j+1]=*(const __attribute__((address_space(3))) bf16x8*)(kp+j*2048+512); }
__device__ __forceinline__ s16x4 vtr(lds_cptr p){ return __builtin_bit_cast(s16x4,__builtin_amdgcn_ds_read_tr16_b64_v4i16((__attribute__((address_space(3))) v4i16_t*)p)); }
__device__ __forceinline__ float rowmax(const f32x16&p0,const f32x16&p1){
  float a=max3f(p0[0],p0[1],p1[0]),b=max3f(p0[2],p0[3],p1[1]);a=max3f(a,p1[2],p1[3]);
  #pragma unroll
  for(int r=4;r<16;r+=4){a=max3f(a,p0[r],p0[r+1]);b=max3f(b,p0[r+2],p0[r+3]);a=max3f(a,p1[r],p1[r+1]);b=max3f(b,p1[r+2],p1[r+3]);}
  const float m=max2f(a,b);
  auto rr=__builtin_amdgcn_permlane32_swap(__float_as_uint(m),__float_as_uint(m),false,false);
  return max2f(__uint_as_float(rr[0]),__uint_as_float(rr[1]));
}
__device__ __forceinline__ void pv(f32x16*o,int vb,bf16x8 pa0,bf16x8 pa1,bf16x8 pa2,bf16x8 pa3){
  #pragma unroll
  for(int d0=0;d0<2;++d0){s16x4 lo[4],hi[4];
    #pragma unroll
    for(int ks=0;ks<4;++ks){
      asm volatile("ds_read_b64_tr_b16 %0,%1 offset:%c2":"=&v"(lo[ks]):"v"(vb),"i"(d0*4096+ks*1024):"memory");
      asm volatile("ds_read_b64_tr_b16 %0,%1 offset:%c2":"=&v"(hi[ks]):"v"(vb),"i"(d0*4096+ks*1024+512):"memory");}
    asm volatile("s_waitcnt lgkmcnt(0)":::"memory");SBAR();
    #define PK(k) (bf16x8){lo[k][0],lo[k][1],lo[k][2],lo[k][3],hi[k][0],hi[k][1],hi[k][2],hi[k][3]}
    o[d0]=__builtin_amdgcn_mfma_f32_32x32x16_bf16(pa0,PK(0),o[d0],0,0,0);
    o[d0]=__builtin_amdgcn_mfma_f32_32x32x16_bf16(pa1,PK(1),o[d0],0,0,0);
    o[d0]=__builtin_amdgcn_mfma_f32_32x32x16_bf16(pa2,PK(2),o[d0],0,0,0);
    o[d0]=__builtin_amdgcn_mfma_f32_32x32x16_bf16(pa3,PK(3),o[d0],0,0,0);
    #undef PK
  }
}

#ifndef ATTN_STORE16
#define ATTN_STORE16(p,v) (*(u32x4*)(p)=(v))
#endif
template<int MODE,int THRL> __device__ __forceinline__ void attn_unit(int b,int h,int qb,const bf16*Q,const bf16*__restrict__ K,const bf16*__restrict__ V,bf16*O,float*SSQ,int hidx,const float*cbg,char*shm){
  int tid_=threadIdx.x; asm volatile("":"+v"(tid_));
  const int tid=tid_,lane=tid&63,r32=lane&31,hi=lane>>5; const int wid=__builtin_amdgcn_readfirstlane(tid>>6);
  const long rowbase=(long)b*SEQ; const int q0=qb*QB; const int tlo=(MODE==1)?((4*qb-8)>0?(4*qb-8):0):0;
  const bf16*Qw=Q+(rowbase+q0+wid*QBLK)*DM+h*D;
  const bf16*Kh=K+(rowbase+tlo*KVBLK)*DM+h*D,*Vh=V+(rowbase+tlo*KVBLK)*DM+h*D;
  const unsigned lds0=(unsigned)(uintptr_t)shm;
  float*wsf=(float*)(shm+LDS_WS)+wid*64;
  const bf16*ksrc=Kh+(long)lane*DM+wid*8;
  const bf16*vsrc=Vh+(long)(16*(wid&3)+(lane>>2))*DM+(wid>>2)*32+(lane&3)*8;
  const unsigned kdst=lds0+LDS_K+wid*1024, vdst=lds0+LDS_V+wid*1024;
  #define DMA_K(t,slot) glds16(ksrc+(long)(t)*KVBLK*DM,(unsigned)__builtin_amdgcn_readfirstlane(kdst+(slot)))
  #define DMA_V(t,slot) glds16(vsrc+(long)(t)*KVBLK*DM,(unsigned)__builtin_amdgcn_readfirstlane(vdst+(slot)))
  const int vb0=(int)(lds0+LDS_V)+((lane>>4)&1)*32+(lane&3)*8+(4*hi+((lane&15)>>2))*64;
  const char*Kbase=shm+LDS_K; bf16x8 kf[8];
  const lds_cptr shm3=(lds_cptr)shm; const lds_cptr kp0=shm3+LDS_K+hi*1024+r32*16; const lds_cptr vp0=shm3+LDS_V+((lane>>4)&1)*32+(lane&3)*8+(4*hi+((lane&15)>>2))*64;
  const int NT=(q0+QB)/KVBLK-tlo;
  glds16(cbg+wid*256+lane*4,(unsigned)__builtin_amdgcn_readfirstlane(lds0+LDS_CB+wid*1024));
  DMA_K(0,0);DMA_V(0,0);DMA_K(1,SLOTB);
  bf16x8 qr[4];
  #pragma unroll
  for(int d0=0;d0<4;++d0)qr[d0]=*reinterpret_cast<const bf16x8*>(&Qw[(long)r32*DM+d0*16+hi*8]);
  float mhat=0.f,l_reg=0.f;f32x16 o[2];o[0]=f32x16{};o[1]=f32x16{};f32x16 negm=f32x16{};asm volatile("":"+v"(negm));
  const int qrel=wid*QBLK+r32;
  typedef __attribute__((address_space(3))) const float* lds_fptr; typedef float f32x4a __attribute__((ext_vector_type(4)));
  const lds_fptr cb3=(lds_fptr)(shm3+LDS_CB); const float NEGB=-8192.f;
  const int cw=4*qb+(wid>>1);
  const int qabs=q0+wid*QBLK+r32;
  #define CMASK(P0,P1,t) do{int jb_=(t)-(NT-4); if(MODE==0&&jb_>=0)cmask(P0,P1,jb_,qrel,hi);}while(0)
  #define POST(P0,P1,t) do{ if(NOPOST){} else \
    if(MODE==0){ const lds_fptr cp_=cb3+(t)*64+4*hi; \
      _Pragma("unroll") for(int g_=0;g_<4;++g_){ const f32x4a a_=*(const __attribute__((address_space(3))) f32x4a*)(cp_+8*g_); const f32x4a b_=*(const __attribute__((address_space(3))) f32x4a*)(cp_+32+8*g_); \
        _Pragma("unroll") for(int i_=0;i_<4;++i_){P0[4*g_+i_]+=a_[i_];P1[4*g_+i_]+=b_[i_];} } \
    } else { const int tabs_=tlo+(t); const int j_=cw-tabs_; \
      if(j_<0||j_>8){ _Pragma("unroll") for(int r_=0;r_<16;++r_){P0[r_]=NEGB;P1[r_]=NEGB;} } \
      else if(j_<=2){ const int base_=qabs-64*tabs_-4*hi; \
        _Pragma("unroll") for(int r_=0;r_<16;++r_){ const int d0_=base_-((r_&3)+8*(r_>>2)); const int i0_=(d0_<128?d0_:128)+128; const int d1_=d0_-32; const int i1_=(d1_<128?d1_:128)+128; \
          P0[r_]+=cb3[i0_]; P1[r_]+=cb3[i1_]; } } \
    } }while(0)
  bool resc=false;
  #define START(P0,P1) do{ const float rm=rowmax(P0,P1); resc=false; \
    { const float dl=rm; mhat=fadd_s(mhat,dl); \
      _Pragma("unroll") for(int r=0;r<16;++r){P0[r]=fsub_s(P0[r],dl);P1[r]=fsub_s(P1[r],dl);} \
      _Pragma("unroll") for(int r=0;r<16;++r)negm[r]=-mhat; asm volatile("":"+v"(negm)); } \
    _Pragma("unroll") for(int r=0;r<16;++r)P0[r]=__builtin_amdgcn_exp2f(P0[r]); }while(0)
  #define RESC() do{ if(resc){ asm volatile("s_waitcnt lgkmcnt(0)":::"memory"); \
      _Pragma("unroll") for(int d_=0;d_<2;++d_) _Pragma("unroll") for(int r=0;r<16;++r)o[d_][r]*=wsf[crow(r,hi)]; } }while(0)
  f32x16 pA0,pA1,pB0,pB1;
  int sl_prev=0,sl_cur=0,sl_next=SLOTB;
  #define ROT() do{sl_prev=sl_cur;sl_cur=sl_next;sl_next=(sl_next==(NSLOT-1)*SLOTB)?0:sl_next+SLOTB;}while(0)
  DMA_K(2,2*SLOTB);
  WAIT_BAR(3);
  qkt(pA0,pA1,Kbase,qr,negm,r32,hi);asm volatile("s_nop 15\n\ts_nop 7":"+v"(pA0),"+v"(pA1));POST(pA0,pA1,0);CMASK(pA0,pA1,0);
  START(pA0,pA1);
  _Pragma("unroll") for(int r=0;r<16;++r)pA1[r]=__builtin_amdgcn_exp2f(pA1[r]);
  WAIT_BAR(0);
  DMA_K(3,0);DMA_V(1,SLOTB);
  ROT();
  kload8(kf,kp0+sl_cur);
  WAIT_BAR(2);
  s16x4 vlo[8],vhi[8]; u32x4 pw0,pw1,pw2,pw3;
  #define PKW(P,B) cvtpk_s(P[B],P[B+1])
  #define PAF(k) __builtin_bit_cast(bf16x8,pw##k)
  #define VFR(i) (bf16x8){vlo[i][0],vlo[i][1],vlo[i][2],vlo[i][3],vhi[i][0],vhi[i][1],vhi[i][2],vhi[i][3]}
  #define PIN(x) asm volatile("":"+v"(x))
  #define MX3(a,b,c) __builtin_fmaxf(__builtin_fmaxf((a),(b)),(c))
  #define GAPA(MF,A0,A1,A2,A3,W0,W1,PW) do{ MF; sacc+=A0; sacc+=A1; sacc+=A2; sacc+=A3; PIN(sacc); W0; W1; PIN(PW); SBAR(); }while(0)
  #define EX(v) __builtin_amdgcn_exp2f(v)
  #define GAPB(MF,X,B) do{ MF; X[B]=EX(X[B]); X[B+1]=EX(X[B+1]); X[B+2]=EX(X[B+2]); X[B+3]=EX(X[B+3]); PIN(X); SBAR(); }while(0)
  #define VRD(i) do{ vlo[i]=vtr(vp_+(((i)>>2)*4096+((i)&3)*1024)); vhi[i]=vtr(vp_+(((i)>>2)*4096+((i)&3)*1024+512)); }while(0)
  #define KRD(G,j) do{ if(G){ kload2(kf,kp0+sl_next,j); SBAR(); } }while(0)
  #define STEP(C0,C1,P0,P1,t,GK,GV,GL) do{ SBAR(); \
    const lds_cptr vp_=vp0+sl_prev; \
    VRD(0); SBAR(); float sacc=(P0[0]+P0[1]); \
    GAPA(C0=__builtin_amdgcn_mfma_f32_32x32x16_bf16(kf[0],qr[0],negm,0,0,0), P0[2],P0[3],P0[4],P0[5],     pw0[0]=PKW(P0,0), pw0[1]=PKW(P0,2), pw0); \
    VRD(4); SBAR(); GAPA(C1=__builtin_amdgcn_mfma_f32_32x32x16_bf16(kf[1],qr[0],negm,0,0,0), P0[6],P0[7],P0[8],P0[9],     pw0[2]=PKW(P0,4), pw0[3]=PKW(P0,6), pw0); \
    VRD(1); SBAR(); GAPA(C0=__builtin_amdgcn_mfma_f32_32x32x16_bf16(kf[2],qr[1],C0,0,0,0),   P0[10],P0[11],P0[12],P0[13], pw1[0]=PKW(P0,8), pw1[1]=PKW(P0,10), pw1); \
    VRD(5); SBAR(); GAPA(C1=__builtin_amdgcn_mfma_f32_32x32x16_bf16(kf[3],qr[1],C1,0,0,0),   P0[14],P0[15],P1[0],P1[1],   pw1[2]=PKW(P0,12),pw1[3]=PKW(P0,14), pw1); \
    VRD(2); SBAR(); GAPA(C0=__builtin_amdgcn_mfma_f32_32x32x16_bf16(kf[4],qr[2],C0,0,0,0),   P1[2],P1[3],P1[4],P1[5],     pw2[0]=PKW(P1,0), pw2[1]=PKW(P1,2), pw2); \
    VRD(6); SBAR(); GAPA(C1=__builtin_amdgcn_mfma_f32_32x32x16_bf16(kf[5],qr[2],C1,0,0,0),   P1[6],P1[7],P1[8],P1[9],     pw2[2]=PKW(P1,4), pw2[3]=PKW(P1,6), pw2); \
    VRD(3); SBAR(); GAPA(C0=__builtin_amdgcn_mfma_f32_32x32x16_bf16(kf[6],qr[3],C0,0,0,0),   P1[10],P1[11],P1[12],P1[13], pw3[0]=PKW(P1,8), pw3[1]=PKW(P1,10), pw3); \
    VRD(7); SBAR(); GAPA(C1=__builtin_amdgcn_mfma_f32_32x32x16_bf16(kf[7],qr[3],C1,0,0,0),   P1[14],P1[15],0.f,0.f,       pw3[2]=PKW(P1,12),pw3[3]=PKW(P1,14), pw3); \
    l_reg+=sacc; \
    if(GK){DMA_K((t)+3,sl_cur);} if(GV){DMA_V((t)+1,sl_next);} \
    POST(C0,C1,t); CMASK(C0,C1,t); \
    { float a=MX3(C0[0],C0[1],C1[0]),b=MX3(C0[2],C0[3],C1[1]); a=MX3(a,C1[2],C1[3]); \
      _Pragma("unroll") for(int r=4;r<16;r+=4){a=MX3(a,C0[r],C0[r+1]);b=MX3(b,C0[r+2],C0[r+3]);a=MX3(a,C1[r],C1[r+1]);b=MX3(b,C1[r+2],C1[r+3]);} \
      float rm=__builtin_fmaxf(a,b); { auto rr=__builtin_amdgcn_permlane32_swap(__float_as_uint(rm),__float_as_uint(rm),false,false); rm=__builtin_fmaxf(__uint_as_float(rr[0]),__uint_as_float(rr[1])); } \
      resc=false; \
      if(__builtin_expect(__any(rm>(float)THRL),0)){ const float dl=__builtin_fmaxf(rm,0.f); mhat+=dl; \
        _Pragma("unroll") for(int r=0;r<16;++r){C0[r]-=dl;C1[r]-=dl;} \
        _Pragma("unroll") for(int r=0;r<16;++r)negm[r]=-mhat; asm volatile("":"+v"(negm)); \
        const float f=__builtin_amdgcn_exp2f(-dl); l_reg*=f; if(hi==0)wsf[r32]=f; resc=true; } } \
    SBAR(); \
    GAPB(o[0]=__builtin_amdgcn_mfma_f32_32x32x16_bf16(PAF(0),VFR(0),o[0],0,0,0), C0,0); \
    GAPB(o[1]=__builtin_amdgcn_mfma_f32_32x32x16_bf16(PAF(0),VFR(4),o[1],0,0,0), C0,4); \
    KRD(GL,0); GAPB(o[0]=__builtin_amdgcn_mfma_f32_32x32x16_bf16(PAF(1),VFR(1),o[0],0,0,0), C0,8); \
    KRD(GL,1); GAPB(o[1]=__builtin_amdgcn_mfma_f32_32x32x16_bf16(PAF(1),VFR(5),o[1],0,0,0), C0,12); \
    KRD(GL,2); GAPB(o[0]=__builtin_amdgcn_mfma_f32_32x32x16_bf16(PAF(2),VFR(2),o[0],0,0,0), C1,0); \
    KRD(GL,3); GAPB(o[1]=__builtin_amdgcn_mfma_f32_32x32x16_bf16(PAF(2),VFR(6),o[1],0,0,0), C1,4); \
    GAPB(o[0]=__builtin_amdgcn_mfma_f32_32x32x16_bf16(PAF(3),VFR(3),o[0],0,0,0), C1,8); \
    GAPB(o[1]=__builtin_amdgcn_mfma_f32_32x32x16_bf16(PAF(3),VFR(7),o[1],0,0,0), C1,12); \
    }while(0)
  int t=1;
  #undef CMASK
  #define CMASK(P0,P1,t) do{}while(0)
  for(;t+5<NT;t+=2){
    STEP(pB0,pB1,pA0,pA1,t,true,true,true);     WAIT_BAR(2); RESC(); ROT();
    STEP(pA0,pA1,pB0,pB1,t+1,true,true,true);   WAIT_BAR(2); RESC(); ROT();
  }
  #undef CMASK
  #define CMASK(P0,P1,t) do{int jb_=(t)-(NT-4); if(MODE==0&&jb_>=0)cmask(P0,P1,jb_,qrel,hi);}while(0)
  #define ENDW(tt) do{ if((tt)+3<NT){WAIT_BAR(2);} else if((tt)+2<NT){WAIT_BAR(1);} else {WAIT_BAR(0);} }while(0)
  for(;t+1<NT;t+=2){
    STEP(pB0,pB1,pA0,pA1,t,(t+3<NT),(t+1<NT),(t+1<NT));       ENDW(t);   RESC(); ROT();
    STEP(pA0,pA1,pB0,pB1,t+1,(t+4<NT),(t+2<NT),(t+2<NT));     ENDW(t+1); RESC(); ROT();
  }
  STEP(pB0,pB1,pA0,pA1,NT-1,false,false,false); RESC();
  { float sacc=pB0[0]+pB0[1]; _Pragma("unroll") for(int r=2;r<16;++r)sacc+=pB0[r]; _Pragma("unroll") for(int r=0;r<16;++r)sacc+=pB1[r]; l_reg+=sacc;
    pw0=(u32x4){PKW(pB0,0),PKW(pB0,2),PKW(pB0,4),PKW(pB0,6)};pw1=(u32x4){PKW(pB0,8),PKW(pB0,10),PKW(pB0,12),PKW(pB0,14)};pw2=(u32x4){PKW(pB1,0),PKW(pB1,2),PKW(pB1,4),PKW(pB1,6)};pw3=(u32x4){PKW(pB1,8),PKW(pB1,10),PKW(pB1,12),PKW(pB1,14)};
    SBAR(); pv(o,vb0+sl_cur,PAF(0),PAF(1),PAF(2),PAF(3)); }
  #undef PKW
  #undef PAF
  #undef VFR
  #undef PIN
  #undef MX3
  #undef GAPA
  #undef GAPB
  #undef EX
  #undef VRD
  #undef KRD
  #undef STEP
  #undef ENDW
  {auto rr=__builtin_amdgcn_permlane32_swap(__float_as_uint(l_reg),__float_as_uint(l_reg),false,false);l_reg=__uint_as_float(rr[0])+__uint_as_float(rr[1]);}
  if(hi==0)wsf[32+r32]=l_reg;asm volatile("s_waitcnt lgkmcnt(0)":::"memory");
  float rli[16];
  #pragma unroll
  for(int r=0;r<16;++r)rli[r]=__builtin_amdgcn_rcpf(wsf[32+crow(r,hi)]);
  bf16*Ow=O+(rowbase+q0+wid*QBLK)*DMO+h*D;
  { bf16*stg=(bf16*)(shm+LDS_OST)+wid*2048;
    #pragma unroll
    for(int r=0;r<16;++r){const int orow=crow(r,hi);
      #pragma unroll
      for(int d0=0;d0<2;++d0)stg[orow*64+d0*32+r32]=__float2bfloat16(o[d0][r]*rli[r]);}
    asm volatile("s_waitcnt lgkmcnt(0)":::"memory");
    #pragma unroll
    for(int i=0;i<4;++i){const int row=i*8+(lane>>3),ch=lane&7; const u32x4 v=*(const u32x4*)(stg+row*64+ch*8); ATTN_STORE16(Ow+(long)row*DMO+ch*8,v);
      if(!NOSSQ){float sq=0.f;
      #pragma unroll
      for(int e=0;e<4;++e){const float lo_=__uint_as_float(v[e]<<16),hi_=__uint_as_float(v[e]&0xffff0000u);sq+=lo_*lo_+hi_*hi_;}
      sq+=__shfl_xor(sq,1);sq+=__shfl_xor(sq,2);sq+=__shfl_xor(sq,4);
      if(ch==0)SSQ[(rowbase+q0+wid*QBLK+row)*16+hidx]=sq;}} }
  asm volatile("s_waitcnt lgkmcnt(0)\n\ts_barrier":::"memory");
  #undef DMA_K
  #undef DMA_V
  #undef POST
  #undef CMASK
  #undef START
  #undef RESC
  #undef ROT
}
constexpr int ATTN_LDS_BYTES=LDS_TOTAL;
#undef SBAR
#undef WAIT_BAR
}
constexpr int NWAVES = 8;
constexpr size_t MiB = 1u << 20;
constexpr size_t WS_WIN = 2 * MiB, WS_WOUT = 8 * MiB, WS_WGU = 10 * MiB, WS_WDN = 21 * MiB;
constexpr size_t WS_CBP = 28 * MiB, WS_CBS = 29 * MiB, WS_TAB = 29 * MiB + 512 * 1024, WS_SSQ = 30 * MiB;
constexpr size_t WS_CTL = 0, WS_MIXS = 32 * MiB + 256 * 1024;
constexpr size_t WS_XN = 33 * MiB;
constexpr size_t WS_XN2 = 98 * MiB;
constexpr size_t WS_QKV = 163 * MiB;
constexpr size_t WS_FF = 357 * MiB;
constexpr size_t WS_END = 487 * MiB;
static_assert(WS_XN + (size_t)MPAD * 1024 * 2 <= WS_XN2 && WS_XN2 + (size_t)MPAD * 1024 * 2 <= WS_QKV && WS_QKV + (size_t)MPAD * 3072 * 2 <= WS_FF && WS_FF + (size_t)MPAD * 1024 * 4 <= WS_END, "ws map");
static_assert(WS_SSQ + (size_t)MPAD * 16 * 4 <= WS_XN && WS_WDN + (size_t)1024 * DFF * 2 <= WS_CBP && WS_WGU + (size_t)NGU * 1024 * 2 <= WS_WDN, "ws map 2");
constexpr int RING_BYTES = 131072, TAB_OFF = RING_BYTES  , LDS_BYTES = 147456;

#define LAS __attribute__((address_space(3)))
typedef unsigned short bf16;
typedef unsigned v4u __attribute__((ext_vector_type(4)));
typedef float f32x4 __attribute__((ext_vector_type(4)));
__device__ __forceinline__ unsigned f2bf(float f) { unsigned u = __builtin_bit_cast(unsigned, f); return (u + 0x7fffu + ((u >> 16) & 1u)) >> 16; }
__device__ __forceinline__ unsigned pk2(float lo, float hi) { return f2bf(lo) | (f2bf(hi) << 16); }
__device__ __forceinline__ float bf2f(bf16 b) { return __uint_as_float((unsigned)b << 16); }
__device__ __forceinline__ float wave_sum(float v) {
#pragma unroll
    for (int o = 1; o < 64; o <<= 1) v += __shfl_xor(v, o);
    return v;
}
__device__ __forceinline__ float wave_max(float v) {
#pragma unroll
    for (int o = 1; o < 64; o <<= 1) v = fmaxf(v, __shfl_xor(v, o));
    return v;
}

#ifndef PH
#define PH 255
#endif
#ifndef DUP
#define DUP 0
#endif
#ifndef AM
#define AM 7
#endif
#define XB_TMO      128
#define XB_XCNT(j)  (256  + 64 * (j))
#define XB_XSUB(j)  (1280 + 64 * (j))
#define XB_XGEN(j)  (2304 + 64 * (j))
#define XB_TOP      3328
#define XB_TOPGEN   3392
#define XCD_BAR_WORDS 3456
#define XB_SPIN_CAP (1u << 18)

__device__ __forceinline__ unsigned xb_ld(unsigned* p)              { return __hip_atomic_load(p, __ATOMIC_RELAXED, __HIP_MEMORY_SCOPE_AGENT); }
__device__ __forceinline__ unsigned xb_add(unsigned* p, unsigned v) { return __hip_atomic_fetch_add(p, v, __ATOMIC_RELAXED, __HIP_MEMORY_SCOPE_AGENT); }
__device__ __forceinline__ unsigned xb_xcc_id() { return (unsigned)__builtin_amdgcn_s_getreg((3 << 11) | 20) & 0xFu; }
#define XB_SPIN(cond, bar) do { unsigned _sp = 0; while (cond) { __builtin_amdgcn_s_sleep(1); \
    if ((++_sp & 255u) == 0u) { if (xb_ld(&(bar)[XB_TMO])) break; if (_sp > XB_SPIN_CAP) { atomicAdd(&(bar)[XB_TMO], 1u); break; } } } } while (0)

struct XcdBarrier {
    unsigned* bar; unsigned x;
    volatile LAS unsigned* st;
};

__device__ __forceinline__ XcdBarrier xcd_barrier_post(unsigned* bar, volatile LAS unsigned* st) {
    XcdBarrier b; b.bar = bar; b.x = xb_xcc_id(); b.st = st;
    if (threadIdx.x == 0) (void)xb_add(&bar[XB_XCNT(b.x)], 1u);
    return b;
}
__device__ __forceinline__ void xcd_barrier_complete(unsigned* bar, unsigned x, unsigned& nloc, unsigned& nx) {
    const unsigned G = gridDim.x * gridDim.y * gridDim.z;
    unsigned sum, cnt, mine, sp = 0u;
    for (;;) {
        sum = 0u; cnt = 0u; mine = 0u;
#pragma unroll
        for (unsigned j = 0; j < 16; ++j) { const unsigned c = xb_ld(&bar[XB_XCNT(j)]); sum += c; cnt += (c > 0u) ? 1u : 0u; mine = (j == x) ? c : mine; }
        if (sum == G) break;
        __builtin_amdgcn_s_sleep(1);
        if ((++sp & 255u) == 0u) { if (xb_ld(&bar[XB_TMO])) break; if (sp > XB_SPIN_CAP) { atomicAdd(&bar[XB_TMO], 1u); break; } }
    }
    nloc = mine > 0u ? mine : 1u; nx = cnt > 0u ? cnt : 1u;
}

__device__ __forceinline__ void xcd_barrier(const XcdBarrier& b) {
    asm volatile("s_waitcnt vmcnt(0)" ::: "memory");
    __syncthreads();
    if (threadIdx.x == 0) {
        unsigned* bar = b.bar;
        __builtin_amdgcn_s_waitcnt(0);
        unsigned nloc = b.st[0], nx = b.st[1];
        if (nloc == 0u) { xcd_barrier_complete(bar, b.x, nloc, nx); b.st[0] = nloc; b.st[1] = nx; }
        const unsigned old = xb_add(&bar[XB_XSUB(b.x)], 1u);
        const unsigned gen = old / nloc;
        if (old + 1u == (gen + 1u) * nloc) {
            __builtin_amdgcn_fence(__ATOMIC_RELEASE, "agent");
            asm volatile("s_waitcnt vmcnt(0)" ::: "memory");
            const unsigned og = xb_add(&bar[XB_TOP], 1u);
            const unsigned tg = og / nx;
            if (og + 1u == (tg + 1u) * nx) xb_add(&bar[XB_TOPGEN], 1u);
            else XB_SPIN(xb_ld(&bar[XB_TOPGEN]) == tg, bar);
            __builtin_amdgcn_fence(__ATOMIC_ACQUIRE, "agent");
            xb_add(&bar[XB_XGEN(b.x)], 1u);
            asm volatile("s_waitcnt vmcnt(0)" ::: "memory");
        } else {
            XB_SPIN(xb_ld(&bar[XB_XGEN(b.x)]) == gen, bar);
            __builtin_amdgcn_fence(__ATOMIC_ACQUIRE, "agent");
            asm volatile("s_waitcnt vmcnt(0)" ::: "memory");
        }
    }
    __syncthreads();
}

struct Args { const float* in[20]; float* out; unsigned char* ws; };

__device__ __forceinline__ void p0_transpose_item(const float* src, int ldw, bf16* dst, int Kd, const float* kscale, LAS float* scr, int lane) {
#pragma unroll 8
    for (int i = 0; i < 32; ++i) { const int kk = 2 * i + (lane >> 5); float v = src[(size_t)kk * ldw + (lane & 31)]; if (kscale) v *= kscale[kk]; scr[kk * 33 + (lane & 31)] = v; }
    asm volatile("s_waitcnt lgkmcnt(0)" ::: "memory");
    const int c = lane & 7;
#pragma unroll
    for (int j = 0; j < 4; ++j) { const int n = (lane >> 3) + 8 * j; const LAS float* s = scr + (8 * c) * 33 + n;
        v4u o; o.x = pk2(s[0 * 33], s[1 * 33]); o.y = pk2(s[2 * 33], s[3 * 33]); o.z = pk2(s[4 * 33], s[5 * 33]); o.w = pk2(s[6 * 33], s[7 * 33]);
        *(v4u*)(dst + (size_t)n * Kd + 8 * c) = o; }
    asm volatile("s_waitcnt lgkmcnt(0)" ::: "memory");
}

__device__ __forceinline__ void sample_attn_item(const Args& a, unsigned char* ws, LAS unsigned char* lds, int item) {
    int tid_ = threadIdx.x; asm volatile("" : "+v"(tid_)); const int tid = tid_, lane = tid & 63, wave = __builtin_amdgcn_readfirstlane(tid >> 6);
    const int type = item >> 6, s = (item >> 3) & 7, h = item & 7;
    const int ncache = type ? BLEN : PAST, nk = ncache + STOK;
    const float* Kc = (type ? a.in[5] : a.in[2]) + (size_t)s * ncache * 512 + h * 64;
    const float* Vc = (type ? a.in[6] : a.in[3]) + (size_t)s * ncache * 512 + h * 64;
    const float* Kn = a.out + (type ? O_BKS : O_AKS) + (size_t)s * STOK * 512 + h * 64;
    const float* Vn = a.out + (type ? O_BVS : O_AVS) + (size_t)s * STOK * 512 + h * 64;
    const bf16* QKV = (const bf16*)(ws + WS_QKV);
    bf16* O = (bf16*)(ws + WS_XN);
    float* SSQ = (float*)(ws + WS_SSQ);
    const float* cbg = type ? (const float*)(ws + WS_TAB) + h * 2048 : (const float*)(ws + WS_CBS) + (size_t)(s * 8 + h) * 1040;
    LAS float* QL = (LAS float*)lds;
    LAS float* SC = (LAS float*)(lds + 4096);
    constexpr int SCP = 1088;
    for (int e = tid; e < 1024; e += 512) { const int i = e >> 6, d = e & 63; QL[e] = bf2f(QKV[(size_t)(MP + s * STOK + i) * NQKV + (type ? 1536 : 0) + h * 64 + d]); }
    __syncthreads();
    const int i0 = 2 * wave, i1 = i0 + 1;
    float m0 = -INFINITY, m1 = -INFINITY;
    for (int blk = 0; blk * 64 < nk; ++blk) {
        const int j = blk * 64 + lane;
        if (j < nk) {
            const float* kr = j < ncache ? Kc + (size_t)j * 512 : Kn + (size_t)(j - ncache) * 512;
            float s0 = 0.f, s1 = 0.f;
#pragma unroll
            for (int d = 0; d < 64; d += 4) { const f32x4 kv = *(const f32x4*)(kr + d); const f32x4 qa = *(const LAS f32x4*)(QL + i0 * 64 + d), qb = *(const LAS f32x4*)(QL + i1 * 64 + d);
                s0 += kv[0] * qa[0] + kv[1] * qa[1] + kv[2] * qa[2] + kv[3] * qa[3]; s1 += kv[0] * qb[0] + kv[1] * qb[1] + kv[2] * qb[2] + kv[3] * qb[3]; }
            if (type == 0) { const float bb = cbg[j]; s0 += bb; s1 += bb; if (j > ncache + i0) s0 = -INFINITY; if (j > ncache + i1) s1 = -INFINITY; }
            else { int d0 = i0 + BLEN - j; d0 = d0 < -128 ? -128 : (d0 > 128 ? 128 : d0); int d1 = i1 + BLEN - j; d1 = d1 < -128 ? -128 : (d1 > 128 ? 128 : d1); s0 += cbg[d0 + 128]; s1 += cbg[d1 + 128]; }
            SC[i0 * SCP + j] = s0; SC[i1 * SCP + j] = s1; m0 = fmaxf(m0, s0); m1 = fmaxf(m1, s1);
        }
    }
    m0 = wave_max(m0); m1 = wave_max(m1);
    float l0 = 0.f, l1 = 0.f;
    for (int blk = 0; blk * 64 < nk; ++blk) { const int j = blk * 64 + lane;
        if (j < nk) { const float p0 = __builtin_amdgcn_exp2f(SC[i0 * SCP + j] - m0), p1 = __builtin_amdgcn_exp2f(SC[i1 * SCP + j] - m1); SC[i0 * SCP + j] = p0; SC[i1 * SCP + j] = p1; l0 += p0; l1 += p1; } }
    l0 = wave_sum(l0); l1 = wave_sum(l1);
    __syncthreads();
    float o0 = 0.f, o1 = 0.f;
    for (int j = 0; j < nk; j += 4) {
        const float* vr = j < ncache ? Vc + (size_t)j * 512 : Vn + (size_t)(j - ncache) * 512;
        const f32x4 pa = *(const LAS f32x4*)(SC + i0 * SCP + j), pb = *(const LAS f32x4*)(SC + i1 * SCP + j);
        const float v0 = vr[lane], v1 = vr[512 + lane], v2 = vr[1024 + lane], v3 = vr[1536 + lane];
        o0 += pa[0] * v0 + pa[1] * v1 + pa[2] * v2 + pa[3] * v3; o1 += pb[0] * v0 + pb[1] * v1 + pb[2] * v2 + pb[3] * v3;
    }
    o0 /= l0; o1 /= l1;
    const unsigned b0 = f2bf(o0), b1 = f2bf(o1);
    const size_t r0 = (size_t)(MP + s * STOK + i0), r1 = r0 + 1;
    O[r0 * 1024 + type * 512 + h * 64 + lane] = (bf16)b0; O[r1 * 1024 + type * 512 + h * 64 + lane] = (bf16)b1;
    const float f0 = __uint_as_float(b0 << 16), f1 = __uint_as_float(b1 << 16);
    const float q0 = wave_sum(f0 * f0), q1 = wave_sum(f1 * f1);
    if (lane == 0) { SSQ[r0 * 16 + type * 8 + h] = q0; SSQ[r1 * 16 + type * 8 + h] = q1; }
    __syncthreads();
}


__device__ __forceinline__ void rowpass_mix(const float* mixrow, const float* xrow, float* yrow, bf16* xn2row, const f32x4 (&g1)[4], const f32x4 (&g2)[4], int lane) {
    const f32x4* mr = (const f32x4*)mixrow + lane; const f32x4* xr = (const f32x4*)xrow + lane;
    f32x4 v[4], x[4]; float ss = 0.f;
#pragma unroll
    for (int j = 0; j < 4; ++j) { v[j] = mr[64 * j]; x[j] = xr[64 * j]; ss += (v[j][0] * v[j][0] + v[j][1] * v[j][1]) + (v[j][2] * v[j][2] + v[j][3] * v[j][3]); }
    const float rstd = 1.0f / sqrtf(wave_sum(ss) * (1.f / 1024.f) + EPS);
    float s2 = 0.f; f32x4* yr = (f32x4*)yrow + lane;
#pragma unroll
    for (int j = 0; j < 4; ++j) { x[j] = x[j] + v[j] * rstd * g1[j]; yr[64 * j] = x[j]; s2 += (x[j][0] * x[j][0] + x[j][1] * x[j][1]) + (x[j][2] * x[j][2] + x[j][3] * x[j][3]); }
    const float r2 = 1.0f / sqrtf(wave_sum(s2) * (1.f / 1024.f) + EPS);
    unsigned long long* o8 = (unsigned long long*)xn2row + lane;
#pragma unroll
    for (int j = 0; j < 4; ++j) { const f32x4 t = x[j] * r2 * g2[j]; o8[64 * j] = (unsigned long long)pk2(t[0], t[1]) | ((unsigned long long)pk2(t[2], t[3]) << 32); }
}
__device__ __forceinline__ void rowpass_ff(const float* ffrow, float* yrow, const f32x4 (&g3)[4], int lane) {
    const f32x4* fr = (const f32x4*)ffrow + lane; f32x4* yr = (f32x4*)yrow + lane;
    f32x4 v[4], x[4]; float ss = 0.f;
#pragma unroll
    for (int j = 0; j < 4; ++j) { v[j] = fr[64 * j]; x[j] = yr[64 * j]; ss += (v[j][0] * v[j][0] + v[j][1] * v[j][1]) + (v[j][2] * v[j][2] + v[j][3] * v[j][3]); }
    const float rstd = 1.0f / sqrtf(wave_sum(ss) * (1.f / 1024.f) + EPS);
#pragma unroll
    for (int j = 0; j < 4; ++j) yr[64 * j] = x[j] + v[j] * rstd * g3[j];
}

typedef short bf16x8v __attribute__((ext_vector_type(8)));
template <int U> __device__ __forceinline__ void skinny_k(const bf16* Arow, const bf16* B0row, const bf16* B1row, int ksteps, f32x4& acc0, f32x4& acc1) {
    const bf16x8v* ap = (const bf16x8v*)Arow; const bf16x8v* b0p = (const bf16x8v*)B0row; const bf16x8v* b1p = (const bf16x8v*)B1row;
    for (int k0 = 0; k0 < ksteps; k0 += U) {
        bf16x8v av[U], b0[U], b1[U];
#pragma unroll
        for (int u = 0; u < U; ++u) { av[u] = ap[4 * (k0 + u)]; b0[u] = b0p[4 * (k0 + u)]; b1[u] = b1p[4 * (k0 + u)]; }
#pragma unroll
        for (int u = 0; u < U; ++u) { acc0 = __builtin_amdgcn_mfma_f32_16x16x32_bf16(b0[u], av[u], acc0, 0, 0, 0); acc1 = __builtin_amdgcn_mfma_f32_16x16x32_bf16(b1[u], av[u], acc1, 0, 0, 0); }
    }
}
__device__ __forceinline__ void slab_rendezvous(unsigned* cnt, unsigned total, int tid) {
    __threadfence(); __syncthreads();
    if (tid == 0) { __hip_atomic_fetch_add(cnt, 1u, __ATOMIC_RELAXED, __HIP_MEMORY_SCOPE_AGENT);
        unsigned spins = 0; while (__hip_atomic_load(cnt, __ATOMIC_RELAXED, __HIP_MEMORY_SCOPE_AGENT) < total && ++spins < (1u << 22)) __builtin_amdgcn_s_sleep(2); }
    __syncthreads(); __threadfence();
}
#define SK_TID() int tid_ = threadIdx.x; asm volatile("" : "+v"(tid_)); const int tid = tid_, lane = tid & 63, wave = __builtin_amdgcn_readfirstlane(tid >> 6), fr = lane & 15, fq = lane >> 4, row = 16 * wave + fr; (void)tid
__device__ __forceinline__ void s1_slab(int j, const bf16* XN, const bf16* Win_t, bf16* QKV, float* out) {
    SK_TID();
    f32x4 acc[2] = {(f32x4){0.f, 0.f, 0.f, 0.f}, (f32x4){0.f, 0.f, 0.f, 0.f}};
    skinny_k<16>(XN + (size_t)(MP + row) * 1024 + 8 * fq, Win_t + (size_t)(32 * j + fr) * 1024 + 8 * fq, Win_t + (size_t)(32 * j + 16 + fr) * 1024 + 8 * fq, 32, acc[0], acc[1]);
    const int type = (32 * j) >> 9; const float sc = (type == 0 || type == 3) ? C2 : 1.f;
    float* fb = (type == 1) ? out + O_AKS : (type == 2) ? out + O_AVS : (type == 4) ? out + O_BKS : (type == 5) ? out + O_BVS : nullptr;
#pragma unroll
    for (int f = 0; f < 2; ++f) { const int col = 32 * j + 16 * f + 4 * fq; const f32x4 v = acc[f];
        if (fb) *(f32x4*)(fb + (size_t)row * 512 + (col & 511)) = v;
        *(unsigned long long*)(QKV + (size_t)(MP + row) * NQKV + col) = (unsigned long long)pk2(v[0] * sc, v[1] * sc) | ((unsigned long long)pk2(v[2] * sc, v[3] * sc) << 32); }
}
__device__ __forceinline__ void s3_slab(int j, const bf16* O, const bf16* Wout_t, const float* SSQ, float* MIXS) {
    SK_TID();
    const f32x4* sp = (const f32x4*)(SSQ + (size_t)(MP + row) * 16); const f32x4 s0 = sp[0], s1 = sp[1], s2 = sp[2], s3 = sp[3];
    const float qa = ((s0[0] + s0[1]) + (s0[2] + s0[3])) + ((s1[0] + s1[1]) + (s1[2] + s1[3])), qb = ((s2[0] + s2[1]) + (s2[2] + s2[3])) + ((s3[0] + s3[1]) + (s3[2] + s3[3]));
    const float ra = 1.0f / sqrtf(qa * (1.f / 512.f) + EPS), rb = 1.0f / sqrtf(qb * (1.f / 512.f) + EPS);
    f32x4 acc[2] = {(f32x4){0.f, 0.f, 0.f, 0.f}, (f32x4){0.f, 0.f, 0.f, 0.f}};
    const bf16* ar = O + (size_t)(MP + row) * 1024 + 8 * fq; const bf16* b0 = Wout_t + (size_t)(32 * j + fr) * 1024 + 8 * fq; const bf16* b1 = b0 + 16 * 1024;
    skinny_k<16>(ar, b0, b1, 16, acc[0], acc[1]);
    const float rr = ra / rb; acc[0] = acc[0] * rr; acc[1] = acc[1] * rr;
    skinny_k<16>(ar + 512, b0 + 512, b1 + 512, 16, acc[0], acc[1]);
#pragma unroll
    for (int f = 0; f < 2; ++f) *(f32x4*)(MIXS + (size_t)row * 1024 + 32 * j + 16 * f + 4 * fq) = acc[f] * rb;
}
__device__ __forceinline__ void s4_slab(int j, const bf16* XN2, const bf16* Wgu_t, bf16* H) {
    SK_TID();
    const int g0 = 256 * ((16 * j) >> 7) + ((16 * j) & 127);
    f32x4 acc[2] = {(f32x4){0.f, 0.f, 0.f, 0.f}, (f32x4){0.f, 0.f, 0.f, 0.f}};
    skinny_k<16>(XN2 + (size_t)(MP + row) * 1024 + 8 * fq, Wgu_t + (size_t)(g0 + fr) * 1024 + 8 * fq, Wgu_t + (size_t)(g0 + 128 + fr) * 1024 + 8 * fq, 32, acc[0], acc[1]);
    float hv[4];
#pragma unroll
    for (int e = 0; e < 4; ++e) { const float g = acc[0][e], up = acc[1][e]; hv[e] = g * up * __builtin_amdgcn_rcpf(1.0f + __builtin_amdgcn_exp2f(-g * LOG2E)); }
    *(unsigned long long*)(H + (size_t)(MP + row) * DFF + 16 * j + 4 * fq) = (unsigned long long)pk2(hv[0], hv[1]) | ((unsigned long long)pk2(hv[2], hv[3]) << 32);
}
__device__ __forceinline__ void s5_slab(int j, const bf16* H, const bf16* Wdn_t, float* FFS) {
    SK_TID();
    f32x4 acc[2] = {(f32x4){0.f, 0.f, 0.f, 0.f}, (f32x4){0.f, 0.f, 0.f, 0.f}};
    skinny_k<11>(H + (size_t)(MP + row) * DFF + 8 * fq, Wdn_t + (size_t)(32 * j + fr) * DFF + 8 * fq, Wdn_t + (size_t)(32 * j + 16 + fr) * DFF + 8 * fq, DFF / 32, acc[0], acc[1]);
#pragma unroll
    for (int f = 0; f < 2; ++f) *(f32x4*)(FFS + (size_t)row * 1024 + 32 * j + 16 * f + 4 * fq) = acc[f];
}

__global__ void __launch_bounds__(NWAVES * 64, 2) fwd_megakernel(Args a) {
    extern __shared__ __attribute__((aligned(16))) unsigned char lds_raw[];
    cg::grid_group grid = cg::this_grid();
    LAS unsigned char* lds = (LAS unsigned char*)lds_raw;
#define FRESH_TID() int tid_ = threadIdx.x; asm volatile("" : "+v"(tid_)); const int tid = tid_, lane = tid & 63, wave = __builtin_amdgcn_readfirstlane(tid >> 6); const int gw = vcu * NWAVES + wave; (void)lane; (void)gw
    const int G = gridDim.x, bx = blockIdx.x;
    const int vcu = (G % 8 == 0) ? (bx % 8) * (G / 8) + bx / 8 : bx;
    unsigned char* ws = a.ws;
    const float* xp = a.in[0]; const float* xs = a.in[1];
    bf16* Win_t = (bf16*)(ws + WS_WIN); bf16* Wout_t = (bf16*)(ws + WS_WOUT); bf16* Wgu_t = (bf16*)(ws + WS_WGU); bf16* Wdn_t = (bf16*)(ws + WS_WDN);
    bf16* XN = (bf16*)(ws + WS_XN); bf16* XN2 = (bf16*)(ws + WS_XN2); bf16* QKV = (bf16*)(ws + WS_QKV); bf16* HB = (bf16*)(ws + WS_QKV);
    float* MIX = (float*)(ws + WS_QKV); float* FF = (float*)(ws + WS_FF); float* SSQ = (float*)(ws + WS_SSQ);
    float* CBP = (float*)(ws + WS_CBP); float* CBS = (float*)(ws + WS_CBS); float* TAB = (float*)(ws + WS_TAB);
    float* Y = a.out + O_Y; float* MIXS = (float*)(ws + WS_MIXS); unsigned* ctl = (unsigned*)(ws + WS_CTL); LAS unsigned* lflag = (LAS unsigned*)(lds + TAB_OFF + 2048);
    const int NGW = G * NWAVES;
    volatile LAS unsigned* bst = (volatile LAS unsigned*)(lds + TAB_OFF + 4096);
    if (threadIdx.x < 2) bst[threadIdx.x] = 0u;
    __syncthreads();
    const XcdBarrier bar = xcd_barrier_post(ctl + 4096, bst);
    if (gridDim.y == 12345u) grid.sync();

#if PH & 1
    for (int rep_ = 0; rep_ < ((DUP & 1) ? 2 : 1); ++rep_) {
        FRESH_TID();
        LAS float* scr = (LAS float*)(lds + wave * 16384);
        constexpr int I_IN = 16 * 96, I_OUT = 16 * 32, I_G = 16 * 88, I_D = 44 * 32, NITEMS = I_IN + I_OUT + 2 * I_G + I_D;
        for (int it = gw; it < NITEMS; it += NGW) {
            int r = it;
            if (r < I_IN) { const int kb = r / 96, nb = r % 96, n0 = nb * 32, sc0 = n0 < 1536 ? n0 : n0 + 8;
                p0_transpose_item(a.in[8] + (size_t)(kb * 64) * DIN + sc0, DIN, Win_t + (size_t)n0 * 1024 + kb * 64, 1024, nullptr, scr, lane); continue; } r -= I_IN;
            if (r < I_OUT) { const int kb = r / 32, nb = r % 32, k0 = kb * 64; const float* ks = (k0 < 512 ? a.in[11] + k0 : a.in[12] + (k0 - 512));
                p0_transpose_item(a.in[13] + (size_t)k0 * 1024 + nb * 32, 1024, Wout_t + (size_t)(nb * 32) * 1024 + k0, 1024, ks, scr, lane); continue; } r -= I_OUT;
            if (r < 2 * I_G) { const int up = r >= I_G; if (up) r -= I_G; const int kb = r / 88, nb = r % 88, n0 = nb * 32, drow = 256 * (n0 / 128) + (up ? 128 : 0) + (n0 % 128);
                p0_transpose_item((up ? a.in[17] : a.in[16]) + (size_t)(kb * 64) * DFF + n0, DFF, Wgu_t + (size_t)drow * 1024 + kb * 64, 1024, nullptr, scr, lane); continue; } r -= 2 * I_G;
            { const int kb = r / 32, nb = r % 32;
                p0_transpose_item(a.in[18] + (size_t)(kb * 64) * 1024 + nb * 32, 1024, Wdn_t + (size_t)(nb * 32) * DFF + kb * 64, DFF, nullptr, scr, lane); }
        }
        {
            float wf[16][8];
#pragma unroll
            for (int j = 0; j < 4; ++j)
#pragma unroll
                for (int e = 0; e < 4; ++e) { const int k = 256 * j + 4 * lane + e; const f32x4* p = (const f32x4*)(a.in[8] + (size_t)k * DIN + 1536); const f32x4 u0 = p[0], u1 = p[1];
                    wf[4 * j + e][0] = u0[0]; wf[4 * j + e][1] = u0[1]; wf[4 * j + e][2] = u0[2]; wf[4 * j + e][3] = u0[3]; wf[4 * j + e][4] = u1[0]; wf[4 * j + e][5] = u1[1]; wf[4 * j + e][6] = u1[2]; wf[4 * j + e][7] = u1[3]; }
            f32x4 gv[4];
#pragma unroll
            for (int j = 0; j < 4; ++j) gv[j] = ((const f32x4*)a.in[7])[64 * j + lane];
            const float bfv = a.in[9][lane & 7];
            for (int m = gw; m < MTOT; m += NGW) {
                const f32x4* xr = (const f32x4*)(m < MP ? xp + (size_t)m * 1024 : xs + (size_t)(m - MP) * 1024) + lane;
                f32x4 v[4]; float ss = 0.f;
#pragma unroll
                for (int j = 0; j < 4; ++j) { v[j] = xr[64 * j]; ss += (v[j][0] * v[j][0] + v[j][1] * v[j][1]) + (v[j][2] * v[j][2] + v[j][3] * v[j][3]); }
                const float rstd = 1.0f / sqrtf(wave_sum(ss) * (1.f / 1024.f) + EPS);
                float z[8];
#pragma unroll
                for (int c = 0; c < 8; ++c) z[c] = 0.f;
                unsigned long long* o8 = (unsigned long long*)(XN + (size_t)m * 1024) + lane;
#pragma unroll
                for (int j = 0; j < 4; ++j) { v[j] = v[j] * rstd * gv[j];
                    o8[64 * j] = (unsigned long long)pk2(v[j][0], v[j][1]) | ((unsigned long long)pk2(v[j][2], v[j][3]) << 32);
#pragma unroll
                    for (int e = 0; e < 4; ++e)
#pragma unroll
                        for (int c = 0; c < 8; ++c) z[c] += v[j][e] * wf[4 * j + e][c]; }
#pragma unroll
                for (int c = 0; c < 8; ++c) z[c] = wave_sum(z[c]);
                float zz = z[0];
#pragma unroll
                for (int c = 1; c < 8; ++c) zz = (lane == c) ? z[c] : zz;
                if (lane < 8) { const float t = zz + bfv; const float lf = fminf(t, 0.f) - log1pf(expf(-fabsf(t)));
                    if (m < MP) a.out[O_LFP + (size_t)m * 8 + lane] = lf; else a.out[O_LFS + (size_t)(m - MP) * 8 + lane] = lf; }
            }
        }
        for (int i = bx * 512 + tid; i < (MPAD - MTOT) * 1024 * 2 / 16; i += G * 512) ((v4u*)(XN + (size_t)MTOT * 1024))[i] = (v4u){0u, 0u, 0u, 0u};
    }
#endif
    xcd_barrier(bar);

#if PH & 2
    for (int rep_ = 0; rep_ < ((DUP & 2) ? 2 : 1); ++rep_) {
        FRESH_TID();
        if (bx < 192) {
            const bool smp = bx >= 128; const int bb = smp ? (bx - 128) >> 3 : bx >> 3, h = bx & 7; const int n = smp ? PAST + STOK : SEQ;
            float v[4];
#pragma unroll
            for (int e = 0; e < 4; ++e) { const int i = 4 * tid + e; float x = 0.f;
                if (i < n) { if (!smp) x = a.out[O_LFP + ((size_t)bb * SEQ + i) * 8 + h]; else x = i < PAST ? a.in[4][((size_t)bb * PAST + i) * 8 + h] : a.out[O_LFS + ((size_t)bb * STOK + (i - PAST)) * 8 + h]; }
                v[e] = x; }
            v[1] += v[0]; v[2] += v[1]; v[3] += v[2];
            const float tot = v[3]; float sc = tot;
#pragma unroll
            for (int o = 1; o < 64; o <<= 1) { const float t = __shfl_up(sc, o); if (lane >= o) sc += t; }
            LAS float* wt = (LAS float*)lds;
            if (lane == 63) wt[wave] = sc;
            __syncthreads();
            float base = sc - tot;
            for (int w = 0; w < wave; ++w) base += wt[w];
            float* dst = smp ? CBS + (size_t)(bb * 8 + h) * 1040 : CBP + (size_t)(bb * 8 + h) * SEQ;
#pragma unroll
            for (int e = 0; e < 4; ++e) { const int i = 4 * tid + e; if (i < n) dst[i] = -(base + v[e]) * LOG2E; }
        } else if (bx < 224) {
            const int idx = (bx - 192) * 512 + tid, h = idx >> 11, i = idx & 2047; TAB[idx] = i < 256 ? (a.in[10][h * 257 + i] - a.in[10][h * 257 + 256]) * LOG2E : 0.f;
        }
        __syncthreads();
        pg8::Gemm g{XN, Win_t, MP, NQKV, 1024}; pg8::StaticOrder S; S.init(MP, NQKV, G, bx);
        pg8::EpiQKV E{QKV, a.out};
        pg8::gemm_phase<pg8::EpiQKV, pg8::StaticOrder, true, true>(lds, g, S, E);
        for (int j = G - 1 - bx; j < NQKV / 32; j += G) s1_slab(j, XN, Win_t, QKV, a.out);
    }
#endif
    xcd_barrier(bar);

#if PH & 4
    for (int rep_ = 0; rep_ < ((DUP & 4) ? 2 : 1); ++rep_) {
        FRESH_TID();
        using abf = attn_body::bf16;
        const abf* Qb = (const abf*)QKV; abf* Ob = (abf*)XN;
        for (int v = vcu; v < 256; v += G) {
            const int pr = v >> 1, half = v & 1, b = pr >> 3, h = pr & 7;
            const float* cbg = CBP + (size_t)(b * 8 + h) * SEQ; const float* tbg = TAB + h * 2048;
            const unsigned long long sched = half ? 0x89FE12345ull : 0xDCBA067ull;
            const int nun = half ? 9 : 7;
            for (int i = 0; i < nun; ++i) { const int e = (int)((sched >> (4 * i)) & 15ull), qb = e & 7;
                if (e < 8) {
#if AM & 1
                    attn_body::attn_unit<0, 8>(b, h, qb, Qb, Qb + 512, Qb + 1024, Ob, SSQ, h, cbg, (char*)lds_raw);
#endif
                } else {
#if AM & 2
                    attn_body::attn_unit<1, 8>(b, h, qb, Qb + 1536, Qb + 2048, Qb + 2560, Ob + 512, SSQ, 8 + h, tbg, (char*)lds_raw);
#endif
                }
            }
#if AM & 4
            if (half == 0 && pr < 128) sample_attn_item(a, ws, lds, pr);
#endif
        }
    }
#endif
    xcd_barrier(bar);

#if PH & 8
    for (int rep_ = 0; rep_ < ((DUP & 8) ? 2 : 1); ++rep_) {
        FRESH_TID();
        pg8::Gemm g{XN, Wout_t, MP, 1024, 1024}; pg8::StaticOrder S; S.init(MP, 1024, G, bx);
        LAS float* tab = (LAS float*)(lds + TAB_OFF);
        pg8::Unit u;
        for (int i = 0; S.next(i, u); ++i) {
            if (tid < 256) { const f32x4* sp = (const f32x4*)(SSQ + (size_t)(u.pm * 256 + tid) * 16); const f32x4 s0 = sp[0], s1 = sp[1], s2 = sp[2], s3 = sp[3];
                const float qa = ((s0[0] + s0[1]) + (s0[2] + s0[3])) + ((s1[0] + s1[1]) + (s1[2] + s1[3])), qb = ((s2[0] + s2[1]) + (s2[2] + s2[3])) + ((s3[0] + s3[1]) + (s3[2] + s3[3]));
                const float ra = 1.0f / sqrtf(fabsf(qa) * (1.f / 512.f) + EPS), rb = 1.0f / sqrtf(fabsf(qb) * (1.f / 512.f) + EPS);
                tab[2 * tid] = ra / rb; tab[2 * tid + 1] = rb; }
            __syncthreads();
            pg8::EpiF32<true> E{MIX, 1024, tab};
            pg8::gemm_phase<pg8::EpiF32<true>, pg8::OneUnit, false, true>(lds, g, pg8::OneUnit{u}, E);
            __syncthreads();
        }
        if (rep_ == 0) for (int j = G - 1 - bx; j < 32; j += G) {
            s3_slab(j, XN, Wout_t, SSQ, MIXS);
            slab_rendezvous(ctl, 32u, tid);
            if (wave < 4) { const int r = 4 * j + wave;
                f32x4 g1[4], g2[4];
#pragma unroll
                for (int q = 0; q < 4; ++q) { g1[q] = ((const f32x4*)a.in[14])[64 * q + lane]; g2[q] = ((const f32x4*)a.in[15])[64 * q + lane]; }
                rowpass_mix(MIXS + (size_t)r * 1024, xs + (size_t)r * 1024, Y + (size_t)(MP + r) * 1024, XN2 + (size_t)(MP + r) * 1024, g1, g2, lane); }
        }
    }
#endif
    xcd_barrier(bar);

#if PH & 16
    for (int rep_ = 0; rep_ < ((DUP & 16) ? 2 : 1); ++rep_) {
        FRESH_TID();
        f32x4 g1[4], g2[4];
#pragma unroll
        for (int j = 0; j < 4; ++j) { g1[j] = ((const f32x4*)a.in[14])[64 * j + lane]; g2[j] = ((const f32x4*)a.in[15])[64 * j + lane]; }
        for (int m = gw; m < MP; m += NGW) rowpass_mix(MIX + (size_t)m * 1024, xp + (size_t)m * 1024, Y + (size_t)m * 1024, XN2 + (size_t)m * 1024, g1, g2, lane);
    }
#endif
    xcd_barrier(bar);

#if PH & 32
    for (int rep_ = 0; rep_ < ((DUP & 32) ? 2 : 1); ++rep_) {
        FRESH_TID();
        pg8::Gemm g{XN2, Wgu_t, MP, NGU, 1024}; pg8::StaticOrder S; S.init(MP, NGU, G, bx);
        pg8::EpiSwiGLU E{HB};
        pg8::gemm_phase<pg8::EpiSwiGLU, pg8::StaticOrder, true, true>(lds, g, S, E);
        for (int j = G - 1 - bx; j < DFF / 16; j += G) s4_slab(j, XN2, Wgu_t, HB);
    }
#endif
    xcd_barrier(bar);

#if PH & 64
    for (int rep_ = 0; rep_ < ((DUP & 64) ? 2 : 1); ++rep_) {
        FRESH_TID();
        pg8::Gemm g{HB, Wdn_t, MP, 1024, DFF}; pg8::StaticOrder S; S.init(MP, 1024, G, bx);
        pg8::EpiF32<false> E{FF, 1024, nullptr};
        pg8::gemm_phase<pg8::EpiF32<false>, pg8::StaticOrder, true, true>(lds, g, S, E);
        if (rep_ == 0) for (int j = G - 1 - bx; j < 32; j += G) {
            s5_slab(j, HB, Wdn_t, MIXS);
            slab_rendezvous(ctl + 64, 32u, tid);
            if (wave < 4) { const int r = 4 * j + wave;
                f32x4 g3[4];
#pragma unroll
                for (int q = 0; q < 4; ++q) g3[q] = ((const f32x4*)a.in[19])[64 * q + lane];
                rowpass_ff(MIXS + (size_t)r * 1024, Y + (size_t)(MP + r) * 1024, g3, lane); }
        }
    }
#endif
    xcd_barrier(bar);

#if PH & 128
    for (int rep_ = 0; rep_ < ((DUP & 128) ? 2 : 1); ++rep_) {
        FRESH_TID();
        f32x4 g3[4];
#pragma unroll
        for (int j = 0; j < 4; ++j) g3[j] = ((const f32x4*)a.in[19])[64 * j + lane];
        for (int m = gw; m < MP; m += NGW) rowpass_ff(FF + (size_t)m * 1024, Y + (size_t)m * 1024, g3, lane);
    }
#endif
}

extern "C" void kernel_launch(void* const* d_in, const int* in_sizes, int n_in, void* d_out, int out_size, void* d_ws, size_t ws_size, hipStream_t stream) {
    static int grid = 0;
    if (grid == 0) {
        if (n_in != 20 || out_size != (int)O_END || ws_size < WS_END) { fprintf(stderr, "kernel_launch: unexpected shapes (n_in %d, out %d, ws %zu)\n", n_in, out_size, ws_size); grid = -1; return; }
        int dev = 0, cus = 0, per_cu = 0;
        hipGetDevice(&dev); hipDeviceGetAttribute(&cus, hipDeviceAttributeMultiprocessorCount, dev);
        hipFuncSetAttribute((const void*)fwd_megakernel, hipFuncAttributeMaxDynamicSharedMemorySize, LDS_BYTES);
        hipOccupancyMaxActiveBlocksPerMultiprocessor(&per_cu, (const void*)fwd_megakernel, NWAVES * 64, LDS_BYTES);
        (void)hipGetLastError();
        if (per_cu < 1) { fprintf(stderr, "kernel_launch: occupancy query says %d blocks/CU\n", per_cu); per_cu = 1; }
        grid = cus;
    }
    if (grid < 0) return;
    if (hipMemsetAsync((char*)d_ws + WS_CTL, 0, 65536, stream) != hipSuccess) { fprintf(stderr, "kernel_launch: memset of the control words failed\n"); return; }
    Args a{};
    for (int i = 0; i < 20; ++i) a.in[i] = (const float*)d_in[i];
    a.out = (float*)d_out; a.ws = (unsigned char*)d_ws;
    void* args[] = {&a};
    hipError_t e = hipLaunchCooperativeKernel((const void*)fwd_megakernel, dim3(grid), dim3(NWAVES * 64), args, LDS_BYTES, stream);
    if (e != hipSuccess) fprintf(stderr, "cooperative launch failed: %s (grid %d)\n", hipGetErrorString(e), grid);
}
```

```cpp
#include <hip/hip_runtime.h>
#include <hip/hip_cooperative_groups.h>
#include <hip/hip_bf16.h>
#include <cstdio>
#include <cstdint>
#include <cmath>
namespace cg = cooperative_groups;

constexpr int DMODEL = 1024, NB = 16, SEQ = 2048, MP = NB * SEQ  , SBATCH = 8, STOK = 16, MS = SBATCH * STOK  ;
constexpr int MTOT = MP + MS  , MPAD = 33024  , PAST = 1024, BLEN = 512;
constexpr int DFF = 2816, DIN = 3080, NQKV = 3072, NGU = 2 * DFF;
constexpr float EPS = 1e-6f, LOG2E = 1.4426950408889634f;
constexpr float C2 = 0.125f * 1.4426950408889634f;
constexpr size_t O_Y = 0, O_AKP = 33685504, O_AVP = 50462720, O_LFP = 67239936, O_BKP = 67502080, O_BVP = 71696384,
                 O_AKS = 75890688, O_AVS = 75956224, O_LFS = 76021760, O_BKS = 76022784, O_BVS = 76088320, O_END = 76153856;
namespace pg8 {
#define PG8_LAS __attribute__((address_space(3)))
typedef unsigned short bf16_t;
typedef short bf16x8 __attribute__((ext_vector_type(8)));
typedef float f32x4 __attribute__((ext_vector_type(4)));
typedef unsigned u32x4 __attribute__((ext_vector_type(4)));
constexpr int BM = 256, BK = 64, HALF = 128, HTB = HALF * BK * 2  , STAGE_BYTES = 8 * HTB, NXCD = 8, WGM = 8;

__host__ __device__ __forceinline__ int lds_byte(int r, int c) { const int st = (r >> 4) * 2 + (c >> 5), rr = r & 15, cc = c & 31, ob = rr * 64 + cc * 2; return st * 1024 + (ob ^ (((ob >> 9) & 1) << 5)); }
__host__ __device__ __forceinline__ void stage_rc(int b, int& R, int& C) { const int st = b / 1024, sb = b % 1024, swz = sb ^ (((sb >> 9) & 1) << 5); R = (st >> 1) * 16 + swz / 64; C = (st & 1) * 32 + (swz % 64) / 2; }
__host__ __device__ __forceinline__ int perm32(int rho) { const int n = rho >> 4, i = rho & 15; return 8 * (i >> 2) + 4 * n + (i & 3); }

struct Unit { int pm, pn; };
struct Gemm { const bf16_t* A; const bf16_t* Bt; int M, N, K; };

struct StaticOrder {
    int nM, nN, nwg, G, c;
    __host__ __device__ void init(int M, int N, int G_, int c_) { nM = M / BM; nN = N / BM; nwg = nM * nN; G = G_; c = c_; }
    __host__ __device__ bool next(int i, Unit& u) const {
        const long L = (long)i * G + c; if (L >= nwg) return false;
        int wgid = (int)L; { const int q = nwg / NXCD, r = nwg % NXCD, xcd = wgid % NXCD, off = wgid / NXCD; wgid = (xcd < r ? xcd * (q + 1) : r * (q + 1) + (xcd - r) * q) + off; }
        const int nig = WGM * nN, gid = wgid / nig, fm = gid * WGM, gsz = (nM - fm) < WGM ? (nM - fm) : WGM;
        u.pm = fm + ((wgid % nig) % gsz); u.pn = (wgid % nig) / gsz; return true;
    }
    __device__ __forceinline__ void a_ready(const Unit&) const {}
    __device__ __forceinline__ void done(const Unit&) const {}
};

__device__ __forceinline__ unsigned cvt_pk_bf16(float lo, float hi) { unsigned r; asm volatile("v_cvt_pk_bf16_f32 %0, %1, %2" : "=v"(r) : "v"(lo), "v"(hi)); return r; }
struct OneUnit {
    Unit u;
    __device__ __forceinline__ bool next(int i, Unit& o) const { if (i) return false; o = u; return true; }
    __device__ __forceinline__ void a_ready(const Unit&) const {}
    __device__ __forceinline__ void done(const Unit&) const {}
};
typedef float f32x2 __attribute__((ext_vector_type(2)));
struct EpiQKV {
    static constexpr bool PERM = true, AFTER_DRAIN = false, HAS_MID = false; static constexpr int MID_T = -1;
    bf16_t* QKV; float* out;
    __device__ __forceinline__ void mid(f32x4 (&)[2][2][4][2], int, int) const {}
    __device__ __forceinline__ void operator()(const f32x4 (&acc)[2][2][4][2], const Unit& u, int wr, int wc, int fr, int fq) const {
        const int type = u.pn >> 1, colt = (u.pn & 1) * 256 + wc * 32 + 8 * fq;
        const float sc = (type == 0 || type == 3) ? C2 : 1.f;
        const bool sample = (u.pm == MP / 256);
        float* fb = nullptr;
        if (type == 1 || type == 2 || type == 4 || type == 5) {
            if (sample) fb = out + (type == 1 ? O_AKS : type == 2 ? O_AVS : type == 4 ? O_BKS : O_BVS);
            else if (type < 3) fb = out + (type == 1 ? O_AKP : O_AVP) + (size_t)u.pm * 256 * 512;
            else { const int bt = u.pm & 7; if (bt >= 6) fb = out + (type == 4 ? O_BKP : O_BVP) + ((size_t)(u.pm >> 3) * 512 + (size_t)(bt - 6) * 256) * 512; }
        }
#pragma unroll
        for (int ai = 0; ai < 2; ++ai) {
            if (sample && ai == 1) break;
#pragma unroll
            for (int m = 0; m < 4; ++m) { const int rl = ai * HALF + wr * 64 + m * 16 + fr;
                bf16_t* rowp = QKV + (size_t)(u.pm * BM + rl) * NQKV + u.pn * BM + wc * 32 + 8 * fq;
#pragma unroll
                for (int bj = 0; bj < 2; ++bj) { f32x4 v0 = acc[ai][bj][m][0], v1 = acc[ai][bj][m][1];
                    if (fb) { float* fp = fb + (size_t)rl * 512 + colt + bj * HALF; *(f32x4*)fp = v0; *(f32x4*)(fp + 4) = v1; }
                    v0 = v0 * sc; v1 = v1 * sc; u32x4 w; w.x = cvt_pk_bf16(v0[0], v0[1]); w.y = cvt_pk_bf16(v0[2], v0[3]); w.z = cvt_pk_bf16(v1[0], v1[1]); w.w = cvt_pk_bf16(v1[2], v1[3]);
                    *(u32x4*)(rowp + bj * HALF) = w; } }
        }
    }
};
struct EpiSwiGLU {
    static constexpr bool PERM = true, AFTER_DRAIN = false, HAS_MID = false; static constexpr int MID_T = -1;
    bf16_t* H;
    __device__ __forceinline__ void mid(f32x4 (&)[2][2][4][2], int, int) const {}
    __device__ __forceinline__ void operator()(const f32x4 (&acc)[2][2][4][2], const Unit& u, int wr, int wc, int fr, int fq) const {
#pragma unroll
        for (int ai = 0; ai < 2; ++ai)
#pragma unroll
            for (int m = 0; m < 4; ++m) { const int row = u.pm * BM + ai * HALF + wr * 64 + m * 16 + fr;
                float hv[8];
#pragma unroll
                for (int n = 0; n < 2; ++n)
#pragma unroll
                    for (int e = 0; e < 4; ++e) { const float g = acc[ai][0][m][n][e], up = acc[ai][1][m][n][e];
                        hv[4 * n + e] = g * up * __builtin_amdgcn_rcpf(1.0f + __builtin_amdgcn_exp2f(-g * LOG2E)); }
                u32x4 w; w.x = cvt_pk_bf16(hv[0], hv[1]); w.y = cvt_pk_bf16(hv[2], hv[3]); w.z = cvt_pk_bf16(hv[4], hv[5]); w.w = cvt_pk_bf16(hv[6], hv[7]);
                *(u32x4*)(H + (size_t)row * DFF + u.pn * HALF + wc * 32 + 8 * fq) = w; }
    }
};
template <bool MID> struct EpiF32 {
    static constexpr bool PERM = false, AFTER_DRAIN = false, HAS_MID = MID; static constexpr int MID_T = 8;
    float* F; int ldc; const PG8_LAS float* tab;
    __device__ __forceinline__ void mid(f32x4 (&acc)[2][2][4][2], int wr, int fr) const {
#pragma unroll
        for (int ai = 0; ai < 2; ++ai)
#pragma unroll
            for (int m = 0; m < 4; ++m) { const float s = tab[(ai * HALF + wr * 64 + m * 16 + fr) * 2];
#pragma unroll
                for (int bj = 0; bj < 2; ++bj)
#pragma unroll
                    for (int n = 0; n < 2; ++n) acc[ai][bj][m][n] = acc[ai][bj][m][n] * s; }
    }
    __device__ __forceinline__ void operator()(const f32x4 (&acc)[2][2][4][2], const Unit& u, int wr, int wc, int fr, int fq) const {
        const int col0 = u.pn * BM + wc * 32 + 4 * fq;
#pragma unroll
        for (int ai = 0; ai < 2; ++ai)
#pragma unroll
            for (int m = 0; m < 4; ++m) { const int rl = ai * HALF + wr * 64 + m * 16 + fr; const float s = MID ? tab[rl * 2 + 1] : 1.f;
                float* rowp = F + (size_t)(u.pm * BM + rl) * ldc + col0;
#pragma unroll
                for (int bj = 0; bj < 2; ++bj)
#pragma unroll
                    for (int n = 0; n < 2; ++n) *(f32x4*)(rowp + bj * HALF + n * 16) = acc[ai][bj][m][n] * s; }
    }
};

template <class Epi, class Sched, bool ALIGN_EPI = false, bool SP2 = false>
__device__ __forceinline__ void gemm_phase(PG8_LAS unsigned char* lds, const Gemm g, const Sched& S, const Epi& E) {
    int tid_ = threadIdx.x; asm volatile("" : "+v"(tid_));
    const int tid = tid_, wid = __builtin_amdgcn_readfirstlane(tid >> 6), lane = tid & 63, wr = wid >> 2, wc = wid & 3, fr = lane & 15, fq = lane >> 4;
    const int K = g.K, nt = K / BK;
    unsigned voffA[2], voffB[2];
#pragma unroll
    for (int i = 0; i < 2; ++i) { int R, C; stage_rc(tid * 16 + i * 8192, R, C); const int Rb = Epi::PERM ? ((R & ~31) + perm32(R & 31)) : R;
        voffA[i] = (unsigned)(R * K + C) * 2u; voffB[i] = (unsigned)(Rb * K + C) * 2u; }
    const size_t kstep = (size_t)(BK * 2);
    const size_t hstep = (size_t)HALF * K * 2;
    const size_t tstep = 2 * hstep;
    const unsigned ldsw = (unsigned)wid * 1024u;
    const int aoff = lds_byte(wr * 64 + fr, fq * 8), boff = lds_byte(wc * 32 + fr, fq * 8);
#define PG8_SA(b, h) (((b) * 2 + (h)) * HTB)
#define PG8_SB(b, h) ((4 + (b) * 2 + (h)) * HTB)
#define PG8_STAGE(bufoff, gbase, voff) do { _Pragma("unroll") for (int _i = 0; _i < 2; ++_i) \
        __builtin_amdgcn_global_load_lds((const unsigned*)((const char*)(gbase) + (voff)[_i]), (PG8_LAS unsigned*)(lds + (bufoff) + ldsw + _i * 8192), 16, 0, 0); } while (0)
#define PG8_LDA(dst, b, h) do { _Pragma("unroll") for (int m = 0; m < 4; ++m) _Pragma("unroll") for (int k = 0; k < 2; ++k) dst[m][k] = *(const PG8_LAS bf16x8*)(lds + PG8_SA(b, h) + aoff + m * 2048 + k * 1024); } while (0)
#define PG8_LDB(dst, b, h) do { _Pragma("unroll") for (int n = 0; n < 2; ++n) _Pragma("unroll") for (int k = 0; k < 2; ++k) dst[n][k] = *(const PG8_LAS bf16x8*)(lds + PG8_SB(b, h) + boff + n * 2048 + k * 1024); } while (0)
#define PG8_MMA(ai, bj, At, Bt) do { __builtin_amdgcn_s_setprio(1); _Pragma("unroll") for (int m = 0; m < 4; ++m) _Pragma("unroll") for (int n = 0; n < 2; ++n) _Pragma("unroll") for (int k = 0; k < 2; ++k) \
        acc[ai][bj][m][n] = __builtin_amdgcn_mfma_f32_16x16x32_bf16(Bt[n][k], At[m][k], acc[ai][bj][m][n], 0, 0, 0); __builtin_amdgcn_s_setprio(0); } while (0)
#define PG8_WAIT_V(n) asm volatile("s_waitcnt vmcnt(" #n ")" ::: "memory")
#define PG8_WAIT_L(n) asm volatile("s_waitcnt lgkmcnt(" #n ")" ::: "memory")
#define PG8_BAR __builtin_amdgcn_s_barrier()
#define PG8_SCHED __builtin_amdgcn_sched_barrier(0)
    Unit cur, nxt; int ui = 0;
    if (!S.next(0, cur)) return;
    f32x4 acc[2][2][4][2];
#pragma unroll
    for (int a = 0; a < 2; ++a)
#pragma unroll
        for (int b = 0; b < 2; ++b)
#pragma unroll
            for (int m = 0; m < 4; ++m)
#pragma unroll
                for (int n = 0; n < 2; ++n) acc[a][b][m][n] = (f32x4){0.f, 0.f, 0.f, 0.f};
    bf16x8 At[4][2], B0[2][2], B1[2][2];
    const char* cA = (const char*)g.A + (size_t)cur.pm * tstep; const char* cB = (const char*)g.Bt + (size_t)cur.pn * tstep;
    S.a_ready(cur);
    if constexpr (SP2) {
        PG8_STAGE(PG8_SB(0, 0), cB, voffB); PG8_STAGE(PG8_SB(0, 1), cB + hstep, voffB); PG8_STAGE(PG8_SA(0, 0), cA, voffA); PG8_STAGE(PG8_SA(0, 1), cA + hstep, voffA);
        if (wr == 1) PG8_BAR;
        PG8_WAIT_V(2); PG8_BAR;
        PG8_STAGE(PG8_SB(1, 0), cB + kstep, voffB); PG8_STAGE(PG8_SA(1, 0), cA + kstep, voffA); PG8_STAGE(PG8_SB(1, 1), cB + hstep + kstep, voffB);
        PG8_WAIT_V(6); PG8_BAR;
    } else {
        PG8_STAGE(PG8_SB(0, 0), cB, voffB); PG8_STAGE(PG8_SA(0, 0), cA, voffA); PG8_STAGE(PG8_SB(0, 1), cB + hstep, voffB); PG8_STAGE(PG8_SA(0, 1), cA + hstep, voffA);
        if (wr == 1) PG8_BAR;
        PG8_WAIT_V(4); PG8_BAR;
        PG8_STAGE(PG8_SB(1, 0), cB + kstep, voffB); PG8_STAGE(PG8_SA(1, 0), cA + kstep, voffA); PG8_STAGE(PG8_SB(1, 1), cB + hstep + kstep, voffB);
        PG8_WAIT_V(6); PG8_BAR;
    }
    for (;;) {
        const bool has_next = S.next(ui + 1, nxt);
        const char* nA = has_next ? (const char*)g.A + (size_t)nxt.pm * tstep : cA; const char* nB = has_next ? (const char*)g.Bt + (size_t)nxt.pn * tstep : cB;
        for (int t = 0; t < nt; t += 2) {
            const bool last = (t == nt - 2);
            if constexpr (Epi::HAS_MID) { if (t == Epi::MID_T) E.mid(acc, wr, fr); }
            const char* a1 = cA + (size_t)(t + 1) * kstep;
            const char* a2 = last ? nA : cA + (size_t)(t + 2) * kstep; const char* b2 = last ? nB : cB + (size_t)(t + 2) * kstep;
            const char* a3 = a2 + kstep; const char* b3 = b2 + kstep;
            if (last && has_next) S.a_ready(nxt);
            if constexpr (SP2) {
            PG8_LDB(B0, 0, 0); PG8_LDB(B1, 0, 1); PG8_SCHED; PG8_LDA(At, 0, 0); PG8_STAGE(PG8_SA(1, 1), a1 + hstep, voffA);
            PG8_WAIT_V(8); PG8_WAIT_L(0); PG8_BAR; PG8_MMA(0, 0, At, B0); PG8_MMA(0, 1, At, B1); PG8_BAR; PG8_SCHED;
            PG8_LDA(At, 0, 1); PG8_STAGE(PG8_SB(0, 0), b2, voffB); PG8_STAGE(PG8_SB(0, 1), b2 + hstep, voffB); PG8_STAGE(PG8_SA(0, 0), a2, voffA);
            PG8_WAIT_V(8); PG8_WAIT_L(0); PG8_BAR; PG8_MMA(1, 0, At, B0); PG8_MMA(1, 1, At, B1); PG8_BAR; PG8_SCHED;
            PG8_LDB(B0, 1, 0); PG8_LDB(B1, 1, 1); PG8_SCHED; PG8_LDA(At, 1, 0); PG8_STAGE(PG8_SA(0, 1), a2 + hstep, voffA);
            PG8_WAIT_V(8); PG8_WAIT_L(0); PG8_BAR; PG8_MMA(0, 0, At, B0); PG8_MMA(0, 1, At, B1); PG8_BAR; PG8_SCHED;
            PG8_LDA(At, 1, 1); PG8_STAGE(PG8_SB(1, 0), b3, voffB); PG8_STAGE(PG8_SB(1, 1), b3 + hstep, voffB); PG8_STAGE(PG8_SA(1, 0), a3, voffA);
            PG8_WAIT_V(8); PG8_WAIT_L(0); PG8_BAR; PG8_MMA(1, 0, At, B0); PG8_MMA(1, 1, At, B1); PG8_BAR; PG8_SCHED;
            } else {
            PG8_LDB(B0, 0, 0); PG8_SCHED; PG8_LDA(At, 0, 0); PG8_STAGE(PG8_SA(1, 1), a1 + hstep, voffA);
            PG8_WAIT_L(8); PG8_BAR; PG8_WAIT_L(0); PG8_MMA(0, 0, At, B0); PG8_BAR; PG8_SCHED;
            PG8_LDB(B1, 0, 1); PG8_STAGE(PG8_SB(0, 0), b2, voffB);
            PG8_BAR; PG8_WAIT_L(0); PG8_MMA(0, 1, At, B1); PG8_BAR;
            PG8_LDA(At, 0, 1); PG8_STAGE(PG8_SA(0, 0), a2, voffA);
            PG8_BAR; PG8_WAIT_L(0); PG8_MMA(1, 0, At, B0); PG8_BAR; PG8_SCHED;
            PG8_STAGE(PG8_SB(0, 1), b2 + hstep, voffB);
            PG8_WAIT_V(6); PG8_BAR; PG8_MMA(1, 1, At, B1); PG8_BAR;
            PG8_LDB(B0, 1, 0); PG8_SCHED; PG8_LDA(At, 1, 0); PG8_STAGE(PG8_SA(0, 1), a2 + hstep, voffA);
            PG8_WAIT_L(8); PG8_BAR; PG8_WAIT_L(0); PG8_MMA(0, 0, At, B0); PG8_BAR; PG8_SCHED;
            PG8_LDB(B1, 1, 1); PG8_STAGE(PG8_SB(1, 0), b3, voffB);
            PG8_BAR; PG8_WAIT_L(0); PG8_MMA(0, 1, At, B1); PG8_BAR;
            PG8_LDA(At, 1, 1); PG8_STAGE(PG8_SA(1, 0), a3, voffA);
            PG8_BAR; PG8_WAIT_L(0); PG8_MMA(1, 0, At, B0); PG8_BAR; PG8_SCHED;
            PG8_STAGE(PG8_SB(1, 1), b3 + hstep, voffB);
            PG8_WAIT_V(6); PG8_BAR; PG8_MMA(1, 1, At, B1); PG8_BAR;
            }
        }
        if constexpr (ALIGN_EPI) { if (wr == 0) PG8_BAR; }
        if constexpr (!Epi::AFTER_DRAIN) { E(acc, cur, wr, wc, fr, fq); S.done(cur); }
        if (!has_next) break;
#pragma unroll
        for (int a = 0; a < 2; ++a)
#pragma unroll
            for (int b = 0; b < 2; ++b)
#pragma unroll
                for (int m = 0; m < 4; ++m)
#pragma unroll
                    for (int n = 0; n < 2; ++n) acc[a][b][m][n] = (f32x4){0.f, 0.f, 0.f, 0.f};
        cur = nxt; cA = nA; cB = nB; ++ui;
        if constexpr (ALIGN_EPI) { if (wr == 1) PG8_BAR; }
    }
    PG8_WAIT_V(0);
    if constexpr (!ALIGN_EPI) { if (wr == 0) PG8_BAR; }
    PG8_BAR;
    if constexpr (Epi::AFTER_DRAIN) { E.fused(acc, cur, wr, wc, fr, fq, lds, wid, lane); S.done(cur); }
#undef PG8_SA
#undef PG8_SB
#undef PG8_STAGE
#undef PG8_LDA
#undef PG8_LDB
#undef PG8_MMA
#undef PG8_WAIT_V
#undef PG8_WAIT_L
#undef PG8_BAR
#undef PG8_SCHED
}
}
#include <hip/hip_bf16.h>
#include <cmath>
#ifndef NOPOST
#define NOPOST 0
#endif
#ifndef NOSSQ
#define NOSSQ 0
#endif
namespace attn_body {
using bf16=__hip_bfloat16;
using bf16x8=__attribute__((ext_vector_type(8)))short;
using s16x4=__attribute__((ext_vector_type(4)))short;
using f32x16=__attribute__((ext_vector_type(16)))float;
using u32x4=__attribute__((ext_vector_type(4)))unsigned;
constexpr int SEQ=2048,D=64,DM=3072,DMO=1024;
constexpr int NW=8,QBLK=32,QB=QBLK*NW,KVBLK=64,NQB=SEQ/QB;
constexpr int ATTN_PITCH=DM, ATTN_UNIT_ROWS=QB;
__device__ __forceinline__ int crow(int r,int hi){return (r&3)+8*(r>>2)+4*hi;}
#define SBAR() __builtin_amdgcn_sched_barrier(0)
__device__ __forceinline__ void cmask(f32x16&p0,f32x16&p1,int jb,int qrel,int hi){
  const float NEG=-INFINITY; int kb=64*jb+4*hi;
  #pragma unroll
  for(int r=0;r<16;++r){int kv=kb+(r&3)+8*(r>>2); if(kv>qrel)p0[r]=NEG; if(kv+32>qrel)p1[r]=NEG;}
}

constexpr int NSLOT=3, SLOTB=8192;
constexpr int LDS_K=0, LDS_V=NSLOT*SLOTB, LDS_WS=2*NSLOT*SLOTB, LDS_OST=LDS_WS+NW*64*4, LDS_BYTES=LDS_OST+NW*4096, LDS_CB=LDS_BYTES, LDS_TOTAL=LDS_CB+8192;
constexpr float C2=0.125f*1.4426950408889634f;
__device__ __forceinline__ void glds16(const void*gsrc,unsigned lds_dst){unsigned keep;
  asm volatile("s_mov_b32 %0, m0\n\ts_mov_b32 m0, %2\n\ts_nop 0\n\tglobal_load_lds_dwordx4 %1, off\n\ts_mov_b32 m0, %0":"=&s"(keep):"v"(gsrc),"s"(lds_dst):"memory");}
__device__ __forceinline__ float max3f(float a,float b,float c){float r;asm("v_max3_f32 %0, %1, %2, %3":"=v"(r):"v"(a),"v"(b),"v"(c));return r;}
__device__ __forceinline__ float max2f(float a,float b){float r;asm("v_max_f32_e32 %0, %1, %2":"=v"(r):"v"(a),"v"(b));return r;}
__device__ __forceinline__ float fadd_s(float a,float b){float r;asm("v_add_f32_e32 %0, %1, %2":"=v"(r):"v"(a),"v"(b));return r;}
__device__ __forceinline__ float fsub_s(float a,float b){float r;asm("v_sub_f32_e32 %0, %1, %2":"=v"(r):"v"(a),"v"(b));return r;}
typedef float f32x2_t __attribute__((ext_vector_type(2))); typedef __bf16 bf16x2_t __attribute__((ext_vector_type(2)));
__device__ __forceinline__ unsigned cvtpk_s(float lo,float hi){f32x2_t v={lo,hi};bf16x2_t b=__builtin_convertvector(v,bf16x2_t);return __builtin_bit_cast(unsigned,b);}
#define WAIT_BAR(N) asm volatile("s_waitcnt vmcnt(" #N ") lgkmcnt(0)\n\ts_barrier":::"memory")

__device__ __forceinline__ void qkt(f32x16&p0,f32x16&p1,const char*Kslot,const bf16x8*qr,const f32x16&negm,int r32,int hi){
  const char*kb=Kslot+hi*1024+r32*16;
  #pragma unroll
  for(int d0=0;d0<4;++d0){
    const bf16x8 b0=*reinterpret_cast<const bf16x8*>(kb+d0*2048);
    const bf16x8 b1=*reinterpret_cast<const bf16x8*>(kb+d0*2048+512);
    if(d0==0){p0=__builtin_amdgcn_mfma_f32_32x32x16_bf16(b0,qr[0],negm,0,0,0);p1=__builtin_amdgcn_mfma_f32_32x32x16_bf16(b1,qr[0],negm,0,0,0);}
    else{p0=__builtin_amdgcn_mfma_f32_32x32x16_bf16(b0,qr[d0],p0,0,0,0);p1=__builtin_amdgcn_mfma_f32_32x32x16_bf16(b1,qr[d0],p1,0,0,0);}}
}
typedef __attribute__((address_space(3))) const char* lds_cptr;
typedef short v4i16_t __attribute__((ext_vector_type(4)));
__device__ __forceinline__ void kload8(bf16x8*kf,lds_cptr kp){
  kf[0]=*(const __attribute__((address_space(3))) bf16x8*)(kp);      kf[1]=*(const __attribute__((address_space(3))) bf16x8*)(kp+512);
  kf[2]=*(const __attribute__((address_space(3))) bf16x8*)(kp+2048); kf[3]=*(const __attribute__((address_space(3))) bf16x8*)(kp+2560);
  kf[4]=*(const __attribute__((address_space(3))) bf16x8*)(kp+4096); kf[5]=*(const __attribute__((address_space(3))) bf16x8*)(kp+4608);
  kf[6]=*(const __attribute__((address_space(3))) bf16x8*)(kp+6144); kf[7]=*(const __attribute__((address_space(3))) bf16x8*)(kp+6656);
}
__device__ __forceinline__ void kload2(bf16x8*kf,lds_cptr kp,int j){ kf[2*j]=*(const __attribute__((address_space(3))) bf16x8*)(kp+j*2048); kf[2*j+1]=*(const __attribute__((address_space(3))) bf16x8*)(kp+j*2048+512); }
__device__ __forceinline__ s16x4 vtr(lds_cptr p){ return __builtin_bit_cast(s16x4,__builtin_amdgcn_ds_read_tr16_b64_v4i16((__attribute__((address_space(3))) v4i16_t*)p)); }
__device__ __forceinline__ float rowmax(const f32x16&p0,const f32x16&p1){
  float a=max3f(p0[0],p0[1],p1[0]),b=max3f(p0[2],p0[3],p1[1]);a=max3f(a,p1[2],p1[3]);
  #pragma unroll
  for(int r=4;r<16;r+=4){a=max3f(a,p0[r],p0[r+1]);b=max3f(b,p0[r+2],p0[r+3]);a=max3f(a,p1[r],p1[r+1]);b=max3f(b,p1[r+2],p1[r+3]);}
  const float m=max2f(a,b);
  auto rr=__builtin_amdgcn_permlane32_swap(__float_as_uint(m),__float_as_uint(m),false,false);
  return max2f(__uint_as_float(rr[0]),__uint_as_float(rr[1]));
}
__device__ __forceinline__ void pv(f32x16*o,int vb,bf16x8 pa0,bf16x8 pa1,bf16x8 pa2,bf16x8 pa3){
  #pragma unroll
  for(int d0=0;d0<2;++d0){s16x4 lo[4],hi[4];
    #pragma unroll
    for(int ks=0;ks<4;++ks){
      asm volatile("ds_read_b64_tr_b16 %0,%1 offset:%c2":"=&v"(lo[ks]):"v"(vb),"i"(d0*4096+ks*1024):"memory");
      asm volatile("ds_read_b64_tr_b16 %0,%1 offset:%c2":"=&v"(hi[ks]):"v"(vb),"i"(d0*4096+ks*1024+512):"memory");}
    asm volatile("s_waitcnt lgkmcnt(0)":::"memory");SBAR();
    #define PK(k) (bf16x8){lo[k][0],lo[k][1],lo[k][2],lo[k][3],hi[k][0],hi[k][1],hi[k][2],hi[k][3]}
    o[d0]=__builtin_amdgcn_mfma_f32_32x32x16_bf16(pa0,PK(0),o[d0],0,0,0);
    o[d0]=__builtin_amdgcn_mfma_f32_32x32x16_bf16(pa1,PK(1),o[d0],0,0,0);
    o[d0]=__builtin_amdgcn_mfma_f32_32x32x16_bf16(pa2,PK(2),o[d0],0,0,0);
    o[d0]=__builtin_amdgcn_mfma_f32_32x32x16_bf16(pa3,PK(3),o[d0],0,0,0);
    #undef PK
  }
}

#ifndef ATTN_STORE16
#define ATTN_STORE16(p,v) (*(u32x4*)(p)=(v))
#endif
template<int MODE,int THRL> __device__ __forceinline__ void attn_unit(int b,int h,int qb,const bf16*Q,const bf16*__restrict__ K,const bf16*__restrict__ V,bf16*O,float*SSQ,int hidx,const float*cbg,char*shm){
  int tid_=threadIdx.x; asm volatile("":"+v"(tid_));
  const int tid=tid_,lane=tid&63,r32=lane&31,hi=lane>>5; const int wid=__builtin_amdgcn_readfirstlane(tid>>6);
  const long rowbase=(long)b*SEQ; const int q0=qb*QB; const int tlo=(MODE==1)?((4*qb-8)>0?(4*qb-8):0):0;
  const bf16*Qw=Q+(rowbase+q0+wid*QBLK)*DM+h*D;
  const bf16*Kh=K+(rowbase+tlo*KVBLK)*DM+h*D,*Vh=V+(rowbase+tlo*KVBLK)*DM+h*D;
  const unsigned lds0=(unsigned)(uintptr_t)shm;
  float*wsf=(float*)(shm+LDS_WS)+wid*64;
  const bf16*ksrc=Kh+(long)lane*DM+wid*8;
  const bf16*vsrc=Vh+(long)(16*(wid&3)+(lane>>2))*DM+(wid>>2)*32+(lane&3)*8;
  const unsigned kdst=lds0+LDS_K+wid*1024, vdst=lds0+LDS_V+wid*1024;
  #define DMA_K(t,slot) glds16(ksrc+(long)(t)*KVBLK*DM,(unsigned)__builtin_amdgcn_readfirstlane(kdst+(slot)))
  #define DMA_V(t,slot) glds16(vsrc+(long)(t)*KVBLK*DM,(unsigned)__builtin_amdgcn_readfirstlane(vdst+(slot)))
  const int vb0=(int)(lds0+LDS_V)+((lane>>4)&1)*32+(lane&3)*8+(4*hi+((lane&15)>>2))*64;
  const char*Kbase=shm+LDS_K; bf16x8 kf[8];
  const lds_cptr shm3=(lds_cptr)shm; const lds_cptr kp0=shm3+LDS_K+hi*1024+r32*16; const lds_cptr vp0=shm3+LDS_V+((lane>>4)&1)*32+(lane&3)*8+(4*hi+((lane&15)>>2))*64;
  const int NT=(q0+QB)/KVBLK-tlo;
  glds16(cbg+wid*256+lane*4,(unsigned)__builtin_amdgcn_readfirstlane(lds0+LDS_CB+wid*1024));
  DMA_K(0,0);DMA_V(0,0);DMA_K(1,SLOTB);
  bf16x8 qr[4];
  #pragma unroll
  for(int d0=0;d0<4;++d0)qr[d0]=*reinterpret_cast<const bf16x8*>(&Qw[(long)r32*DM+d0*16+hi*8]);
  float mhat=0.f,l_reg=0.f;f32x16 o[2];o[0]=f32x16{};o[1]=f32x16{};f32x16 negm=f32x16{};asm volatile("":"+v"(negm));
  const int qrel=wid*QBLK+r32;
  typedef __attribute__((address_space(3))) const float* lds_fptr; typedef float f32x4a __attribute__((ext_vector_type(4)));
  const lds_fptr cb3=(lds_fptr)(shm3+LDS_CB); const float NEGB=-8192.f;
  const int cw=4*qb+(wid>>1);
  const int qabs=q0+wid*QBLK+r32;
  #define CMASK(P0,P1,t) do{int jb_=(t)-(NT-4); if(MODE==0&&jb_>=0)cmask(P0,P1,jb_,qrel,hi);}while(0)
  #define POST(P0,P1,t) do{ if(NOPOST){} else \
    if(MODE==0){ const lds_fptr cp_=cb3+(t)*64+4*hi; \
      _Pragma("unroll") for(int g_=0;g_<4;++g_){ const f32x4a a_=*(const __attribute__((address_space(3))) f32x4a*)(cp_+8*g_); const f32x4a b_=*(const __attribute__((address_space(3))) f32x4a*)(cp_+32+8*g_); \
        _Pragma("unroll") for(int i_=0;i_<4;++i_){P0[4*g_+i_]+=a_[i_];P1[4*g_+i_]+=b_[i_];} } \
    } else { const int tabs_=tlo+(t); const int j_=cw-tabs_; \
      if(j_<0||j_>8){ _Pragma("unroll") for(int r_=0;r_<16;++r_){P0[r_]=NEGB;P1[r_]=NEGB;} } \
      else if(j_<=2){ const int base_=qabs-64*tabs_-4*hi; \
        _Pragma("unroll") for(int r_=0;r_<16;++r_){ const int d0_=base_-((r_&3)+8*(r_>>2)); const int i0_=(d0_<128?d0_:128)+128; const int d1_=d0_-32; const int i1_=(d1_<128?d1_:128)+128; \
          P0[r_]+=cb3[i0_]; P1[r_]+=cb3[i1_]; } } \
    } }while(0)
  bool resc=false;
  #define START(P0,P1) do{ const float rm=rowmax(P0,P1); resc=false; \
    { const float dl=rm; mhat=fadd_s(mhat,dl); \
      _Pragma("unroll") for(int r=0;r<16;++r){P0[r]=fsub_s(P0[r],dl);P1[r]=fsub_s(P1[r],dl);} \
      _Pragma("unroll") for(int r=0;r<16;++r)negm[r]=-mhat; asm volatile("":"+v"(negm)); } \
    _Pragma("unroll") for(int r=0;r<16;++r)P0[r]=__builtin_amdgcn_exp2f(P0[r]); }while(0)
  #define RESC() do{ if(resc){ asm volatile("s_waitcnt lgkmcnt(0)":::"memory"); \
      _Pragma("unroll") for(int d_=0;d_<2;++d_) _Pragma("unroll") for(int r=0;r<16;++r)o[d_][r]*=wsf[crow(r,hi)]; } }while(0)
  f32x16 pA0,pA1,pB0,pB1;
  int sl_prev=0,sl_cur=0,sl_next=SLOTB;
  #define ROT() do{sl_prev=sl_cur;sl_cur=sl_next;sl_next=(sl_next==(NSLOT-1)*SLOTB)?0:sl_next+SLOTB;}while(0)
  DMA_K(2,2*SLOTB);
  WAIT_BAR(3);
  qkt(pA0,pA1,Kbase,qr,negm,r32,hi);asm volatile("s_nop 15\n\ts_nop 7":"+v"(pA0),"+v"(pA1));POST(pA0,pA1,0);CMASK(pA0,pA1,0);
  START(pA0,pA1);
  _Pragma("unroll") for(int r=0;r<16;++r)pA1[r]=__builtin_amdgcn_exp2f(pA1[r]);
  WAIT_BAR(0);
  DMA_K(3,0);DMA_V(1,SLOTB);
  ROT();
  kload8(kf,kp0+sl_cur);
  WAIT_BAR(2);
  s16x4 vlo[8],vhi[8]; u32x4 pw0,pw1,pw2,pw3;
  #define PKW(P,B) cvtpk_s(P[B],P[B+1])
  #define PAF(k) __builtin_bit_cast(bf16x8,pw##k)
  #define VFR(i) (bf16x8){vlo[i][0],vlo[i][1],vlo[i][2],vlo[i][3],vhi[i][0],vhi[i][1],vhi[i][2],vhi[i][3]}
  #define PIN(x) asm volatile("":"+v"(x))
  #define MX3(a,b,c) __builtin_fmaxf(__builtin_fmaxf((a),(b)),(c))
  #define GAPA(MF,A0,A1,A2,A3,W0,W1,PW) do{ MF; sacc+=A0; sacc+=A1; sacc+=A2; sacc+=A3; PIN(sacc); W0; W1; PIN(PW); SBAR(); }while(0)
  #define EX(v) __builtin_amdgcn_exp2f(v)
  #define GAPB(MF,X,B) do{ MF; X[B]=EX(X[B]); X[B+1]=EX(X[B+1]); X[B+2]=EX(X[B+2]); X[B+3]=EX(X[B+3]); PIN(X); SBAR(); }while(0)
  #define VRD(i) do{ vlo[i]=vtr(vp_+(((i)>>2)*4096+((i)&3)*1024)); vhi[i]=vtr(vp_+(((i)>>2)*4096+((i)&3)*1024+512)); }while(0)
  #define KRD(G,j) do{ if(G){ kload2(kf,kp0+sl_next,j); SBAR(); } }while(0)
  #define STEP(C0,C1,P0,P1,t,GK,GV,GL) do{ SBAR(); \
    const lds_cptr vp_=vp0+sl_prev; \
    VRD(0); SBAR(); float sacc=(P0[0]+P0[1]); \
    GAPA(C0=__builtin_amdgcn_mfma_f32_32x32x16_bf16(kf[0],qr[0],negm,0,0,0), P0[2],P0[3],P0[4],P0[5],     pw0[0]=PKW(P0,0), pw0[1]=PKW(P0,2), pw0); \
    VRD(4); SBAR(); GAPA(C1=__builtin_amdgcn_mfma_f32_32x32x16_bf16(kf[1],qr[0],negm,0,0,0), P0[6],P0[7],P0[8],P0[9],     pw0[2]=PKW(P0,4), pw0[3]=PKW(P0,6), pw0); \
    VRD(1); SBAR(); GAPA(C0=__builtin_amdgcn_mfma_f32_32x32x16_bf16(kf[2],qr[1],C0,0,0,0),   P0[10],P0[11],P0[12],P0[13], pw1[0]=PKW(P0,8), pw1[1]=PKW(P0,10), pw1); \
    VRD(5); SBAR(); GAPA(C1=__builtin_amdgcn_mfma_f32_32x32x16_bf16(kf[3],qr[1],C1,0,0,0),   P0[14],P0[15],P1[0],P1[1],   pw1[2]=PKW(P0,12),pw1[3]=PKW(P0,14), pw1); \
    VRD(2); SBAR(); GAPA(C0=__builtin_amdgcn_mfma_f32_32x32x16_bf16(kf[4],qr[2],C0,0,0,0),   P1[2],P1[3],P1[4],P1[5],     pw2[0]=PKW(P1,0), pw2[1]=PKW(P1,2), pw2); \
    VRD(6); SBAR(); GAPA(C1=__builtin_amdgcn_mfma_f32_32x32x16_bf16(kf[5],qr[2],C1,0,0,0),   P1[6],P1[7],P1[8],P1[9],     pw2[2]=PKW(P1,4), pw2[3]=PKW(P1,6), pw2); \
    VRD(3); SBAR(); GAPA(C0=__builtin_amdgcn_mfma_f32_32x32x16_bf16(kf[6],qr[3],C0,0,0,0),   P1[10],P1[11],P1[12],P1[13], pw3[0]=PKW(P1,8), pw3[1]=PKW(P1,10), pw3); \
    VRD(7); SBAR(); GAPA(C1=__builtin_amdgcn_mfma_f32_32x32x16_bf16(kf[7],qr[3],C1,0,0,0),   P1[14],P1[15],0.f,0.f,       pw3[2]=PKW(P1,12),pw3[3]=PKW(P1,14), pw3); \
    l_reg+=sacc; \
    if(GK){DMA_K((t)+3,sl_cur);} if(GV){DMA_V((t)+1,sl_next);} \
    POST(C0,C1,t); CMASK(C0,C1,t); \
    { float a=MX3(C0[0],C0[1],C1[0]),b=MX3(C0[2],C0[3],C1[1]); a=MX3(a,C1[2],C1[3]); \
      _Pragma("unroll") for(int r=4;r<16;r+=4){a=MX3(a,C0[r],C0[r+1]);b=MX3(b,C0[r+2],C0[r+3]);a=MX3(a,C1[r],C1[r+1]);b=MX3(b,C1[r+2],C1[r+3]);} \
      float rm=__builtin_fmaxf(a,b); { auto rr=__builtin_amdgcn_permlane32_swap(__float_as_uint(rm),__float_as_uint(rm),false,false); rm=__builtin_fmaxf(__uint_as_float(rr[0]),__uint_as_float(rr[1])); } \
      resc=false; \
      if(__builtin_expect(__any(rm>(float)THRL),0)){ const float dl=__builtin_fmaxf(rm,0.f); mhat+=dl; \
        _Pragma("unroll") for(int r=0;r<16;++r){C0[r]-=dl;C1[r]-=dl;} \
        _Pragma("unroll") for(int r=0;r<16;++r)negm[r]=-mhat; asm volatile("":"+v"(negm)); \
        const float f=__builtin_amdgcn_exp2f(-dl); l_reg*=f; if(hi==0)wsf[r32]=f; resc=true; } } \
    SBAR(); \
    GAPB(o[0]=__builtin_amdgcn_mfma_f32_32x32x16_bf16(PAF(0),VFR(0),o[0],0,0,0), C0,0); \
    GAPB(o[1]=__builtin_amdgcn_mfma_f32_32x32x16_bf16(PAF(0),VFR(4),o[1],0,0,0), C0,4); \
    KRD(GL,0); GAPB(o[0]=__builtin_amdgcn_mfma_f32_32x32x16_bf16(PAF(1),VFR(1),o[0],0,0,0), C0,8); \
    KRD(GL,1); GAPB(o[1]=__builtin_amdgcn_mfma_f32_32x32x16_bf16(PAF(1),VFR(5),o[1],0,0,0), C0,12); \
    KRD(GL,2); GAPB(o[0]=__builtin_amdgcn_mfma_f32_32x32x16_bf16(PAF(2),VFR(2),o[0],0,0,0), C1,0); \
    KRD(GL,3); GAPB(o[1]=__builtin_amdgcn_mfma_f32_32x32x16_bf16(PAF(2),VFR(6),o[1],0,0,0), C1,4); \
    GAPB(o[0]=__builtin_amdgcn_mfma_f32_32x32x16_bf16(PAF(3),VFR(3),o[0],0,0,0), C1,8); \
    GAPB(o[1]=__builtin_amdgcn_mfma_f32_32x32x16_bf16(PAF(3),VFR(7),o[1],0,0,0), C1,12); \
    }while(0)
  int t=1;
  #undef CMASK
  #define CMASK(P0,P1,t) do{}while(0)
  for(;t+5<NT;t+=2){
    STEP(pB0,pB1,pA0,pA1,t,true,true,true);     WAIT_BAR(2); RESC(); ROT();
    STEP(pA0,pA1,pB0,pB1,t+1,true,true,true);   WAIT_BAR(2); RESC(); ROT();
  }
  #undef CMASK
  #define CMASK(P0,P1,t) do{int jb_=(t)-(NT-4); if(MODE==0&&jb_>=0)cmask(P0,P1,jb_,qrel,hi);}while(0)
  #define ENDW(tt) do{ if((tt)+3<NT){WAIT_BAR(2);} else if((tt)+2<NT){WAIT_BAR(1);} else {WAIT_BAR(0);} }while(0)
  for(;t+1<NT;t+=2){
    STEP(pB0,pB1,pA0,pA1,t,(t+3<NT),(t+1<NT),(t+1<NT));       ENDW(t);   RESC(); ROT();
    STEP(pA0,pA1,pB0,pB1,t+1,(t+4<NT),(t+2<NT),(t+2<NT));     ENDW(t+1); RESC(); ROT();
  }
  STEP(pB0,pB1,pA0,pA1,NT-1,false,false,false); RESC();
  { float sacc=pB0[0]+pB0[1]; _Pragma("unroll") for(int r=2;r<16;++r)sacc+=pB0[r]; _Pragma("unroll") for(int r=0;r<16;++r)sacc+=pB1[r]; l_reg+=sacc;
    pw0=(u32x4){PKW(pB0,0),PKW(pB0,2),PKW(pB0,4),PKW(pB0,6)};pw1=(u32x4){PKW(pB0,8),PKW(pB0,10),PKW(pB0,12),PKW(pB0,14)};pw2=(u32x4){PKW(pB1,0),PKW(pB1,2),PKW(pB1,4),PKW(pB1,6)};pw3=(u32x4){PKW(pB1,8),PKW(pB1,10),PKW(pB1,12),PKW(pB1,14)};
    SBAR(); pv(o,vb0+sl_cur,PAF(0),PAF(1),PAF(2),PAF(3)); }
  #undef PKW
  #undef PAF
  #undef VFR
  #undef PIN
  #undef MX3
  #undef GAPA
  #undef GAPB
  #undef EX
  #undef VRD
  #undef KRD
  #undef STEP
  #undef ENDW
  {auto rr=__builtin_amdgcn_permlane32_swap(__float_as_uint(l_reg),__float_as_uint(l_reg),false,false);l_reg=__uint_as_float(rr[0])+__uint_as_float(rr[1]);}
  if(hi==0)wsf[32+r32]=l_reg;asm volatile("s_waitcnt lgkmcnt(0)":::"memory");
  float rli[16];
  #pragma unroll
  for(int r=0;r<16;++r)rli[r]=__builtin_amdgcn_rcpf(wsf[32+crow(r,hi)]);
  bf16*Ow=O+(rowbase+q0+wid*QBLK)*DMO+h*D;
  { bf16*stg=(bf16*)(shm+LDS_OST)+wid*2048;
    #pragma unroll
    for(int r=0;r<16;++r){const int orow=crow(r,hi);
      #pragma unroll
      for(int d0=0;d0<2;++d0)stg[orow*64+d0*32+r32]=__float2bfloat16(o[d0][r]*rli[r]);}
    asm volatile("s_waitcnt lgkmcnt(0)":::"memory");
    #pragma unroll
    for(int i=0;i<4;++i){const int row=i*8+(lane>>3),ch=lane&7; const u32x4 v=*(const u32x4*)(stg+row*64+ch*8); ATTN_STORE16(Ow+(long)row*DMO+ch*8,v);
      if(!NOSSQ){float sq=0.f;
      #pragma unroll
      for(int e=0;e<4;++e){const float lo_=__uint_as_float(v[e]<<16),hi_=__uint_as_float(v[e]&0xffff0000u);sq+=lo_*lo_+hi_*hi_;}
      sq+=__shfl_xor(sq,1);sq+=__shfl_xor(sq,2);sq+=__shfl_xor(sq,4);
      if(ch==0)SSQ[(rowbase+q0+wid*QBLK+row)*16+hidx]=sq;}} }
  asm volatile("s_waitcnt lgkmcnt(0)\n\ts_barrier":::"memory");
  #undef DMA_K
  #undef DMA_V
  #undef POST
  #undef CMASK
  #undef START
  #undef RESC
  #undef ROT
}
constexpr int ATTN_LDS_BYTES=LDS_TOTAL;
#undef SBAR
#undef WAIT_BAR
}
constexpr int NWAVES = 8;
constexpr size_t MiB = 1u << 20;
constexpr size_t WS_WIN = 2 * MiB, WS_WOUT = 8 * MiB, WS_WGU = 10 * MiB, WS_WDN = 21 * MiB;
constexpr size_t WS_CBP = 28 * MiB, WS_CBS = 29 * MiB, WS_TAB = 29 * MiB + 512 * 1024, WS_SSQ = 30 * MiB;
constexpr size_t WS_CTL = 0, WS_MIXS = 32 * MiB + 256 * 1024;
constexpr size_t WS_XN = 33 * MiB;
constexpr size_t WS_XN2 = 98 * MiB;
constexpr size_t WS_QKV = 163 * MiB;
constexpr size_t WS_FF = 357 * MiB;
constexpr size_t WS_END = 487 * MiB;
static_assert(WS_XN + (size_t)MPAD * 1024 * 2 <= WS_XN2 && WS_XN2 + (size_t)MPAD * 1024 * 2 <= WS_QKV && WS_QKV + (size_t)MPAD * 3072 * 2 <= WS_FF && WS_FF + (size_t)MPAD * 1024 * 4 <= WS_END, "ws map");
static_assert(WS_SSQ + (size_t)MPAD * 16 * 4 <= WS_XN && WS_WDN + (size_t)1024 * DFF * 2 <= WS_CBP && WS_WGU + (size_t)NGU * 1024 * 2 <= WS_WDN, "ws map 2");
constexpr int RING_BYTES = 131072, TAB_OFF = RING_BYTES  , LDS_BYTES = 147456;

#define LAS __attribute__((address_space(3)))
typedef unsigned short bf16;
typedef unsigned v4u __attribute__((ext_vector_type(4)));
typedef float f32x4 __attribute__((ext_vector_type(4)));
__device__ __forceinline__ unsigned f2bf(float f) { unsigned u = __builtin_bit_cast(unsigned, f); return (u + 0x7fffu + ((u >> 16) & 1u)) >> 16; }
__device__ __forceinline__ unsigned pk2(float lo, float hi) { return f2bf(lo) | (f2bf(hi) << 16); }
__device__ __forceinline__ float bf2f(bf16 b) { return __uint_as_float((unsigned)b << 16); }
__device__ __forceinline__ float wave_sum(float v) {
#pragma unroll
    for (int o = 1; o < 64; o <<= 1) v += __shfl_xor(v, o);
    return v;
}
__device__ __forceinline__ float wave_max(float v) {
#pragma unroll
    for (int o = 1; o < 64; o <<= 1) v = fmaxf(v, __shfl_xor(v, o));
    return v;
}

#ifndef PH
#define PH 255
#endif
#ifndef DUP
#define DUP 0
#endif
#ifndef AM
#define AM 7
#endif
#define XB_TMO      128
#define XB_XCNT(j)  (256  + 64 * (j))
#define XB_XSUB(j)  (1280 + 64 * (j))
#define XB_XGEN(j)  (2304 + 64 * (j))
#define XB_TOP      3328
#define XB_TOPGEN   3392
#define XCD_BAR_WORDS 3456
#define XB_SPIN_CAP (1u << 18)

__device__ __forceinline__ unsigned xb_ld(unsigned* p)              { return __hip_atomic_load(p, __ATOMIC_RELAXED, __HIP_MEMORY_SCOPE_AGENT); }
__device__ __forceinline__ unsigned xb_add(unsigned* p, unsigned v) { return __hip_atomic_fetch_add(p, v, __ATOMIC_RELAXED, __HIP_MEMORY_SCOPE_AGENT); }
__device__ __forceinline__ unsigned xb_xcc_id() { return (unsigned)__builtin_amdgcn_s_getreg((3 << 11) | 20) & 0xFu; }
#define XB_SPIN(cond, bar) do { unsigned _sp = 0; while (cond) { __builtin_amdgcn_s_sleep(1); \
    if ((++_sp & 255u) == 0u) { if (xb_ld(&(bar)[XB_TMO])) break; if (_sp > XB_SPIN_CAP) { atomicAdd(&(bar)[XB_TMO], 1u); break; } } } } while (0)

struct XcdBarrier {
    unsigned* bar; unsigned x;
    volatile LAS unsigned* st;
};

__device__ __forceinline__ XcdBarrier xcd_barrier_post(unsigned* bar, volatile LAS unsigned* st) {
    XcdBarrier b; b.bar = bar; b.x = xb_xcc_id(); b.st = st;
    if (threadIdx.x == 0) (void)xb_add(&bar[XB_XCNT(b.x)], 1u);
    return b;
}
__device__ __forceinline__ void xcd_barrier_complete(unsigned* bar, unsigned x, unsigned& nloc, unsigned& nx) {
    const unsigned G = gridDim.x * gridDim.y * gridDim.z;
    unsigned sum, cnt, mine, sp = 0u;
    for (;;) {
        sum = 0u; cnt = 0u; mine = 0u;
#pragma unroll
        for (unsigned j = 0; j < 16; ++j) { const unsigned c = xb_ld(&bar[XB_XCNT(j)]); sum += c; cnt += (c > 0u) ? 1u : 0u; mine = (j == x) ? c : mine; }
        if (sum == G) break;
        __builtin_amdgcn_s_sleep(1);
        if ((++sp & 255u) == 0u) { if (xb_ld(&bar[XB_TMO])) break; if (sp > XB_SPIN_CAP) { atomicAdd(&bar[XB_TMO], 1u); break; } }
    }
    nloc = mine > 0u ? mine : 1u; nx = cnt > 0u ? cnt : 1u;
}

__device__ __forceinline__ void xcd_barrier(const XcdBarrier& b) {
    asm volatile("s_waitcnt vmcnt(0)" ::: "memory");
    __syncthreads();
    if (threadIdx.x == 0) {
        unsigned* bar = b.bar;
        __builtin_amdgcn_s_waitcnt(0);
        unsigned nloc = b.st[0], nx = b.st[1];
        if (nloc == 0u) { xcd_barrier_complete(bar, b.x, nloc, nx); b.st[0] = nloc; b.st[1] = nx; }
        const unsigned old = xb_add(&bar[XB_XSUB(b.x)], 1u);
        const unsigned gen = old / nloc;
        if (old + 1u == (gen + 1u) * nloc) {
            __builtin_amdgcn_fence(__ATOMIC_RELEASE, "agent");
            asm volatile("s_waitcnt vmcnt(0)" ::: "memory");
            const unsigned og = xb_add(&bar[XB_TOP], 1u);
            const unsigned tg = og / nx;
            if (og + 1u == (tg + 1u) * nx) xb_add(&bar[XB_TOPGEN], 1u);
            else XB_SPIN(xb_ld(&bar[XB_TOPGEN]) == tg, bar);
            __builtin_amdgcn_fence(__ATOMIC_ACQUIRE, "agent");
            xb_add(&bar[XB_XGEN(b.x)], 1u);
            asm volatile("s_waitcnt vmcnt(0)" ::: "memory");
        } else {
            XB_SPIN(xb_ld(&bar[XB_XGEN(b.x)]) == gen, bar);
            __builtin_amdgcn_fence(__ATOMIC_ACQUIRE, "agent");
            asm volatile("s_waitcnt vmcnt(0)" ::: "memory");
        }
    }
    __syncthreads();
}

struct Args { const float* in[20]; float* out; unsigned char* ws; };

__device__ __forceinline__ void p0_transpose_item(const float* src, int ldw, bf16* dst, int Kd, const float* kscale, LAS float* scr, int lane) {
#pragma unroll 8
    for (int i = 0; i < 32; ++i) { const int kk = 2 * i + (lane >> 5); float v = src[(size_t)kk * ldw + (lane & 31)]; if (kscale) v *= kscale[kk]; scr[kk * 33 + (lane & 31)] = v; }
    asm volatile("s_waitcnt lgkmcnt(0)" ::: "memory");
    const int c = lane & 7;
#pragma unroll
    for (int j = 0; j < 4; ++j) { const int n = (lane >> 3) + 8 * j; const LAS float* s = scr + (8 * c) * 33 + n;
        v4u o; o.x = pk2(s[0 * 33], s[1 * 33]); o.y = pk2(s[2 * 33], s[3 * 33]); o.z = pk2(s[4 * 33], s[5 * 33]); o.w = pk2(s[6 * 33], s[7 * 33]);
        *(v4u*)(dst + (size_t)n * Kd + 8 * c) = o; }
    asm volatile("s_waitcnt lgkmcnt(0)" ::: "memory");
}

typedef short bf16x8q __attribute__((ext_vector_type(8)));
__device__ __forceinline__ bf16x8q cvt8(const f32x4 x, const f32x4 y) { v4u r; r.x = pk2(x[0], x[1]); r.y = pk2(x[2], x[3]); r.z = pk2(y[0], y[1]); r.w = pk2(y[2], y[3]); return __builtin_bit_cast(bf16x8q, r); }
__device__ __forceinline__ void sample_attn_item(const Args& a, unsigned char* ws, LAS unsigned char* lds, int item) {
    int tid_ = threadIdx.x; asm volatile("" : "+v"(tid_)); const int tid = tid_, lane = tid & 63, wave = __builtin_amdgcn_readfirstlane(tid >> 6), fr = lane & 15, fq = lane >> 4;
    const int type = item >> 6, s = (item >> 3) & 7, h = item & 7;
    const int ncache = type ? BLEN : PAST, nk = ncache + STOK, ntiles = nk >> 4;
    const float* Kc = (type ? a.in[5] : a.in[2]) + (size_t)s * ncache * 512 + h * 64;
    const float* Vc = (type ? a.in[6] : a.in[3]) + (size_t)s * ncache * 512 + h * 64;
    const float* Kn = a.out + (type ? O_BKS : O_AKS) + (size_t)s * STOK * 512 + h * 64;
    const float* Vn = a.out + (type ? O_BVS : O_AVS) + (size_t)s * STOK * 512 + h * 64;
    const bf16* QKV = (const bf16*)(ws + WS_QKV);
    bf16* O = (bf16*)(ws + WS_XN);
    float* SSQ = (float*)(ws + WS_SSQ);
    const float* cbg = type ? (const float*)(ws + WS_TAB) + h * 2048 : (const float*)(ws + WS_CBS) + (size_t)(s * 8 + h) * 1040;
    constexpr int SCP = 1060;
    LAS float* SC = (LAS float*)lds;
    LAS float* LL = (LAS float*)(lds + 16 * SCP * 4);
    LAS float* OP = (LAS float*)(lds + 16 * SCP * 4 + 256);
    const bf16* qrow = QKV + (size_t)(MP + s * STOK + fr) * NQKV + (type ? 1536 : 0) + h * 64 + 8 * fq;
    const bf16x8q qf0 = *(const bf16x8q*)qrow, qf1 = *(const bf16x8q*)(qrow + 32);
    for (int t0 = wave; t0 < ntiles; t0 += 24) {
        f32x4 kk[3][4];
#pragma unroll
        for (int u = 0; u < 3; ++u) { const int t = t0 + 8 * u, tt = t < ntiles ? t : ntiles - 1, key = 16 * tt + fr;
            const float* kr = (key < ncache ? Kc + (size_t)key * 512 : Kn + (size_t)(key - ncache) * 512) + 8 * fq;
            kk[u][0] = *(const f32x4*)kr; kk[u][1] = *(const f32x4*)(kr + 4); kk[u][2] = *(const f32x4*)(kr + 32); kk[u][3] = *(const f32x4*)(kr + 36); }
        __builtin_amdgcn_sched_barrier(0);
#pragma unroll
        for (int u = 0; u < 3; ++u) { const int t = t0 + 8 * u;
            if (t < ntiles) {
                f32x4 acc = __builtin_amdgcn_mfma_f32_16x16x32_bf16(cvt8(kk[u][0], kk[u][1]), qf0, (f32x4){0.f, 0.f, 0.f, 0.f}, 0, 0, 0);
                acc = __builtin_amdgcn_mfma_f32_16x16x32_bf16(cvt8(kk[u][2], kk[u][3]), qf1, acc, 0, 0, 0);
                const int k0 = 16 * t + 4 * fq;
                if (type == 0) { const f32x4 bb = *(const f32x4*)(cbg + k0); acc = acc + bb;
#pragma unroll
                    for (int e = 0; e < 4; ++e) if (k0 + e > ncache + fr) acc[e] = -INFINITY; }
                else {
#pragma unroll
                    for (int e = 0; e < 4; ++e) { int d = fr + BLEN - (k0 + e); d = d < -128 ? -128 : (d > 128 ? 128 : d); acc[e] += cbg[d + 128]; } }
                *(LAS f32x4*)(SC + fr * SCP + k0) = acc;
            } }
    }
    __syncthreads();
    {
        const int i0 = 2 * wave, i1 = i0 + 1;
        float m0 = -INFINITY, m1 = -INFINITY;
        for (int j = lane; j < nk; j += 64) { m0 = fmaxf(m0, SC[i0 * SCP + j]); m1 = fmaxf(m1, SC[i1 * SCP + j]); }
        m0 = wave_max(m0); m1 = wave_max(m1);
        float l0 = 0.f, l1 = 0.f;
        for (int j = lane; j < nk; j += 64) { const float p0 = __builtin_amdgcn_exp2f(SC[i0 * SCP + j] - m0), p1 = __builtin_amdgcn_exp2f(SC[i1 * SCP + j] - m1); SC[i0 * SCP + j] = p0; SC[i1 * SCP + j] = p1; l0 += p0; l1 += p1; }
        l0 = wave_sum(l0); l1 = wave_sum(l1);
        if (lane == 0) { LL[i0] = l0; LL[i1] = l1; }
    }
    __syncthreads();
    {
        float o[16];
#pragma unroll
        for (int q = 0; q < 16; ++q) o[q] = 0.f;
        for (int t0 = wave; t0 < ntiles; t0 += 16) {
            float vv[2][16];
#pragma unroll
            for (int u = 0; u < 2; ++u) { const int t = t0 + 8 * u, tt = t < ntiles ? t : ntiles - 1;
#pragma unroll
                for (int k = 0; k < 16; ++k) { const int key = 16 * tt + k; vv[u][k] = (key < ncache ? Vc + (size_t)key * 512 : Vn + (size_t)(key - ncache) * 512)[lane]; } }
            __builtin_amdgcn_sched_barrier(0);
#pragma unroll
            for (int u = 0; u < 2; ++u) { const int t = t0 + 8 * u;
                if (t < ntiles) {
#pragma unroll
                    for (int q = 0; q < 16; ++q) {
#pragma unroll
                        for (int g = 0; g < 4; ++g) { const f32x4 p = *(const LAS f32x4*)(SC + q * SCP + 16 * t + 4 * g);
                            o[q] += p[0] * vv[u][4 * g] + p[1] * vv[u][4 * g + 1] + p[2] * vv[u][4 * g + 2] + p[3] * vv[u][4 * g + 3]; } }
                } }
        }
#pragma unroll
        for (int q = 0; q < 16; ++q) OP[(wave * 16 + q) * 64 + lane] = o[q];
    }
    __syncthreads();
#pragma unroll
    for (int r = 0; r < 2; ++r) { const int q = wave + 8 * r; float sum = 0.f;
#pragma unroll
        for (int w = 0; w < 8; ++w) sum += OP[(w * 16 + q) * 64 + lane];
        const float ov = sum / LL[q]; const unsigned b = f2bf(ov); const size_t row = (size_t)(MP + s * STOK + q);
        O[row * 1024 + type * 512 + h * 64 + lane] = (bf16)b;
        const float f = __uint_as_float(b << 16); const float qs = wave_sum(f * f);
        if (lane == 0) SSQ[row * 16 + type * 8 + h] = qs; }
    __syncthreads();
}

__device__ __forceinline__ void rowpass_mix(const float* mixrow, const float* xrow, float* yrow, bf16* xn2row, const f32x4 (&g1)[4], const f32x4 (&g2)[4], int lane) {
    const f32x4* mr = (const f32x4*)mixrow + lane; const f32x4* xr = (const f32x4*)xrow + lane;
    f32x4 v[4], x[4]; float ss = 0.f;
#pragma unroll
    for (int j = 0; j < 4; ++j) { v[j] = mr[64 * j]; x[j] = xr[64 * j]; ss += (v[j][0] * v[j][0] + v[j][1] * v[j][1]) + (v[j][2] * v[j][2] + v[j][3] * v[j][3]); }
    const float rstd = 1.0f / sqrtf(wave_sum(ss) * (1.f / 1024.f) + EPS);
    float s2 = 0.f; f32x4* yr = (f32x4*)yrow + lane;
#pragma unroll
    for (int j = 0; j < 4; ++j) { x[j] = x[j] + v[j] * rstd * g1[j]; yr[64 * j] = x[j]; s2 += (x[j][0] * x[j][0] + x[j][1] * x[j][1]) + (x[j][2] * x[j][2] + x[j][3] * x[j][3]); }
    const float r2 = 1.0f / sqrtf(wave_sum(s2) * (1.f / 1024.f) + EPS);
    unsigned long long* o8 = (unsigned long long*)xn2row + lane;
#pragma unroll
    for (int j = 0; j < 4; ++j) { const f32x4 t = x[j] * r2 * g2[j]; o8[64 * j] = (unsigned long long)pk2(t[0], t[1]) | ((unsigned long long)pk2(t[2], t[3]) << 32); }
}
__device__ __forceinline__ void rowpass_ff(const float* ffrow, float* yrow, const f32x4 (&g3)[4], int lane) {
    const f32x4* fr = (const f32x4*)ffrow + lane; f32x4* yr = (f32x4*)yrow + lane;
    f32x4 v[4], x[4]; float ss = 0.f;
#pragma unroll
    for (int j = 0; j < 4; ++j) { v[j] = fr[64 * j]; x[j] = yr[64 * j]; ss += (v[j][0] * v[j][0] + v[j][1] * v[j][1]) + (v[j][2] * v[j][2] + v[j][3] * v[j][3]); }
    const float rstd = 1.0f / sqrtf(wave_sum(ss) * (1.f / 1024.f) + EPS);
#pragma unroll
    for (int j = 0; j < 4; ++j) yr[64 * j] = x[j] + v[j] * rstd * g3[j];
}

typedef short bf16x8v __attribute__((ext_vector_type(8)));
template <int U> __device__ __forceinline__ void skinny_k(const bf16* Arow, const bf16* B0row, const bf16* B1row, int ksteps, f32x4& acc0, f32x4& acc1) {
    const bf16x8v* ap = (const bf16x8v*)Arow; const bf16x8v* b0p = (const bf16x8v*)B0row; const bf16x8v* b1p = (const bf16x8v*)B1row;
    for (int k0 = 0; k0 < ksteps; k0 += U) {
        bf16x8v av[U], b0[U], b1[U];
#pragma unroll
        for (int u = 0; u < U; ++u) { av[u] = ap[4 * (k0 + u)]; b0[u] = b0p[4 * (k0 + u)]; b1[u] = b1p[4 * (k0 + u)]; }
        __builtin_amdgcn_sched_barrier(0);
#pragma unroll
        for (int u = 0; u < U; ++u) { acc0 = __builtin_amdgcn_mfma_f32_16x16x32_bf16(b0[u], av[u], acc0, 0, 0, 0); acc1 = __builtin_amdgcn_mfma_f32_16x16x32_bf16(b1[u], av[u], acc1, 0, 0, 0); }
    }
}
__device__ __forceinline__ void slab_rendezvous(unsigned* cnt, unsigned total, int tid) {
    __threadfence(); __syncthreads();
    if (tid == 0) { __hip_atomic_fetch_add(cnt, 1u, __ATOMIC_RELAXED, __HIP_MEMORY_SCOPE_AGENT);
        unsigned spins = 0; while (__hip_atomic_load(cnt, __ATOMIC_RELAXED, __HIP_MEMORY_SCOPE_AGENT) < total && ++spins < (1u << 22)) __builtin_amdgcn_s_sleep(2); }
    __syncthreads(); __threadfence();
}
#define SK_TID() int tid_ = threadIdx.x; asm volatile("" : "+v"(tid_)); const int tid = tid_, lane = tid & 63, wave = __builtin_amdgcn_readfirstlane(tid >> 6), fr = lane & 15, fq = lane >> 4, row = 16 * wave + fr; (void)tid
__device__ __forceinline__ void s1_slab(int j, const bf16* XN, const bf16* Win_t, bf16* QKV, float* out) {
    SK_TID();
    f32x4 acc[2] = {(f32x4){0.f, 0.f, 0.f, 0.f}, (f32x4){0.f, 0.f, 0.f, 0.f}};
    skinny_k<16>(XN + (size_t)(MP + row) * 1024 + 8 * fq, Win_t + (size_t)(32 * j + fr) * 1024 + 8 * fq, Win_t + (size_t)(32 * j + 16 + fr) * 1024 + 8 * fq, 32, acc[0], acc[1]);
    const int type = (32 * j) >> 9; const float sc = (type == 0 || type == 3) ? C2 : 1.f;
    float* fb = (type == 1) ? out + O_AKS : (type == 2) ? out + O_AVS : (type == 4) ? out + O_BKS : (type == 5) ? out + O_BVS : nullptr;
#pragma unroll
    for (int f = 0; f < 2; ++f) { const int col = 32 * j + 16 * f + 4 * fq; const f32x4 v = acc[f];
        if (fb) *(f32x4*)(fb + (size_t)row * 512 + (col & 511)) = v;
        *(unsigned long long*)(QKV + (size_t)(MP + row) * NQKV + col) = (unsigned long long)pk2(v[0] * sc, v[1] * sc) | ((unsigned long long)pk2(v[2] * sc, v[3] * sc) << 32); }
}
__device__ __forceinline__ void s3_slab(int j, const bf16* O, const bf16* Wout_t, const float* SSQ, float* MIXS) {
    SK_TID();
    const f32x4* sp = (const f32x4*)(SSQ + (size_t)(MP + row) * 16); const f32x4 s0 = sp[0], s1 = sp[1], s2 = sp[2], s3 = sp[3];
    const float qa = ((s0[0] + s0[1]) + (s0[2] + s0[3])) + ((s1[0] + s1[1]) + (s1[2] + s1[3])), qb = ((s2[0] + s2[1]) + (s2[2] + s2[3])) + ((s3[0] + s3[1]) + (s3[2] + s3[3]));
    const float ra = 1.0f / sqrtf(qa * (1.f / 512.f) + EPS), rb = 1.0f / sqrtf(qb * (1.f / 512.f) + EPS);
    f32x4 acc[2] = {(f32x4){0.f, 0.f, 0.f, 0.f}, (f32x4){0.f, 0.f, 0.f, 0.f}};
    const bf16* ar = O + (size_t)(MP + row) * 1024 + 8 * fq; const bf16* b0 = Wout_t + (size_t)(32 * j + fr) * 1024 + 8 * fq; const bf16* b1 = b0 + 16 * 1024;
    skinny_k<16>(ar, b0, b1, 16, acc[0], acc[1]);
    const float rr = ra / rb; acc[0] = acc[0] * rr; acc[1] = acc[1] * rr;
    skinny_k<16>(ar + 512, b0 + 512, b1 + 512, 16, acc[0], acc[1]);
#pragma unroll
    for (int f = 0; f < 2; ++f) *(f32x4*)(MIXS + (size_t)row * 1024 + 32 * j + 16 * f + 4 * fq) = acc[f] * rb;
}
__device__ __forceinline__ void s4_slab(int j, const bf16* XN2, const bf16* Wgu_t, bf16* H) {
    SK_TID();
    const int g0 = 256 * ((16 * j) >> 7) + ((16 * j) & 127);
    f32x4 acc[2] = {(f32x4){0.f, 0.f, 0.f, 0.f}, (f32x4){0.f, 0.f, 0.f, 0.f}};
    skinny_k<16>(XN2 + (size_t)(MP + row) * 1024 + 8 * fq, Wgu_t + (size_t)(g0 + fr) * 1024 + 8 * fq, Wgu_t + (size_t)(g0 + 128 + fr) * 1024 + 8 * fq, 32, acc[0], acc[1]);
    float hv[4];
#pragma unroll
    for (int e = 0; e < 4; ++e) { const float g = acc[0][e], up = acc[1][e]; hv[e] = g * up * __builtin_amdgcn_rcpf(1.0f + __builtin_amdgcn_exp2f(-g * LOG2E)); }
    *(unsigned long long*)(H + (size_t)(MP + row) * DFF + 16 * j + 4 * fq) = (unsigned long long)pk2(hv[0], hv[1]) | ((unsigned long long)pk2(hv[2], hv[3]) << 32);
}
__device__ __forceinline__ void s5_slab(int j, const bf16* H, const bf16* Wdn_t, float* FFS) {
    SK_TID();
    f32x4 acc[2] = {(f32x4){0.f, 0.f, 0.f, 0.f}, (f32x4){0.f, 0.f, 0.f, 0.f}};
    skinny_k<11>(H + (size_t)(MP + row) * DFF + 8 * fq, Wdn_t + (size_t)(32 * j + fr) * DFF + 8 * fq, Wdn_t + (size_t)(32 * j + 16 + fr) * DFF + 8 * fq, DFF / 32, acc[0], acc[1]);
#pragma unroll
    for (int f = 0; f < 2; ++f) *(f32x4*)(FFS + (size_t)row * 1024 + 32 * j + 16 * f + 4 * fq) = acc[f];
}

__global__ void __launch_bounds__(NWAVES * 64, 2) fwd_megakernel(Args a) {
    extern __shared__ __attribute__((aligned(16))) unsigned char lds_raw[];
    cg::grid_group grid = cg::this_grid();
    LAS unsigned char* lds = (LAS unsigned char*)lds_raw;
#define FRESH_TID() int tid_ = threadIdx.x; asm volatile("" : "+v"(tid_)); const int tid = tid_, lane = tid & 63, wave = __builtin_amdgcn_readfirstlane(tid >> 6); const int gw = vcu * NWAVES + wave; (void)lane; (void)gw
    const int G = gridDim.x, bx = blockIdx.x;
    const int vcu = (G % 8 == 0) ? (bx % 8) * (G / 8) + bx / 8 : bx;
    unsigned char* ws = a.ws;
    const float* xp = a.in[0]; const float* xs = a.in[1];
    bf16* Win_t = (bf16*)(ws + WS_WIN); bf16* Wout_t = (bf16*)(ws + WS_WOUT); bf16* Wgu_t = (bf16*)(ws + WS_WGU); bf16* Wdn_t = (bf16*)(ws + WS_WDN);
    bf16* XN = (bf16*)(ws + WS_XN); bf16* XN2 = (bf16*)(ws + WS_XN2); bf16* QKV = (bf16*)(ws + WS_QKV); bf16* HB = (bf16*)(ws + WS_QKV);
    float* MIX = (float*)(ws + WS_QKV); float* FF = (float*)(ws + WS_FF); float* SSQ = (float*)(ws + WS_SSQ);
    float* CBP = (float*)(ws + WS_CBP); float* CBS = (float*)(ws + WS_CBS); float* TAB = (float*)(ws + WS_TAB);
    float* Y = a.out + O_Y; float* MIXS = (float*)(ws + WS_MIXS); unsigned* ctl = (unsigned*)(ws + WS_CTL); LAS unsigned* lflag = (LAS unsigned*)(lds + TAB_OFF + 2048);
    const int NGW = G * NWAVES;
    volatile LAS unsigned* bst = (volatile LAS unsigned*)(lds + TAB_OFF + 4096);
    if (threadIdx.x < 2) bst[threadIdx.x] = 0u;
    __syncthreads();
    const XcdBarrier bar = xcd_barrier_post(ctl + 4096, bst);
    if (gridDim.y == 12345u) grid.sync();

#if PH & 1
    for (int rep_ = 0; rep_ < ((DUP & 1) ? 2 : 1); ++rep_) {
        FRESH_TID();
        LAS float* scr = (LAS float*)(lds + wave * 16384);
        constexpr int I_IN = 16 * 96, I_OUT = 16 * 32, I_G = 16 * 88, I_D = 44 * 32, NITEMS = I_IN + I_OUT + 2 * I_G + I_D;
        for (int it = gw; it < NITEMS; it += NGW) {
            int r = it;
            if (r < I_IN) { const int kb = r / 96, nb = r % 96, n0 = nb * 32, sc0 = n0 < 1536 ? n0 : n0 + 8;
                p0_transpose_item(a.in[8] + (size_t)(kb * 64) * DIN + sc0, DIN, Win_t + (size_t)n0 * 1024 + kb * 64, 1024, nullptr, scr, lane); continue; } r -= I_IN;
            if (r < I_OUT) { const int kb = r / 32, nb = r % 32, k0 = kb * 64; const float* ks = (k0 < 512 ? a.in[11] + k0 : a.in[12] + (k0 - 512));
                p0_transpose_item(a.in[13] + (size_t)k0 * 1024 + nb * 32, 1024, Wout_t + (size_t)(nb * 32) * 1024 + k0, 1024, ks, scr, lane); continue; } r -= I_OUT;
            if (r < 2 * I_G) { const int up = r >= I_G; if (up) r -= I_G; const int kb = r / 88, nb = r % 88, n0 = nb * 32, drow = 256 * (n0 / 128) + (up ? 128 : 0) + (n0 % 128);
                p0_transpose_item((up ? a.in[17] : a.in[16]) + (size_t)(kb * 64) * DFF + n0, DFF, Wgu_t + (size_t)drow * 1024 + kb * 64, 1024, nullptr, scr, lane); continue; } r -= 2 * I_G;
            { const int kb = r / 32, nb = r % 32;
                p0_transpose_item(a.in[18] + (size_t)(kb * 64) * 1024 + nb * 32, 1024, Wdn_t + (size_t)(nb * 32) * DFF + kb * 64, DFF, nullptr, scr, lane); }
        }
        {
            float wf[16][8];
#pragma unroll
            for (int j = 0; j < 4; ++j)
#pragma unroll
                for (int e = 0; e < 4; ++e) { const int k = 256 * j + 4 * lane + e; const f32x4* p = (const f32x4*)(a.in[8] + (size_t)k * DIN + 1536); const f32x4 u0 = p[0], u1 = p[1];
                    wf[4 * j + e][0] = u0[0]; wf[4 * j + e][1] = u0[1]; wf[4 * j + e][2] = u0[2]; wf[4 * j + e][3] = u0[3]; wf[4 * j + e][4] = u1[0]; wf[4 * j + e][5] = u1[1]; wf[4 * j + e][6] = u1[2]; wf[4 * j + e][7] = u1[3]; }
            f32x4 gv[4];
#pragma unroll
            for (int j = 0; j < 4; ++j) gv[j] = ((const f32x4*)a.in[7])[64 * j + lane];
            const float bfv = a.in[9][lane & 7];
            for (int m = gw; m < MTOT; m += NGW) {
                const f32x4* xr = (const f32x4*)(m < MP ? xp + (size_t)m * 1024 : xs + (size_t)(m - MP) * 1024) + lane;
                f32x4 v[4]; float ss = 0.f;
#pragma unroll
                for (int j = 0; j < 4; ++j) { v[j] = xr[64 * j]; ss += (v[j][0] * v[j][0] + v[j][1] * v[j][1]) + (v[j][2] * v[j][2] + v[j][3] * v[j][3]); }
                const float rstd = 1.0f / sqrtf(wave_sum(ss) * (1.f / 1024.f) + EPS);
                float z[8];
#pragma unroll
                for (int c = 0; c < 8; ++c) z[c] = 0.f;
                unsigned long long* o8 = (unsigned long long*)(XN + (size_t)m * 1024) + lane;
#pragma unroll
                for (int j = 0; j < 4; ++j) { v[j] = v[j] * rstd * gv[j];
                    o8[64 * j] = (unsigned long long)pk2(v[j][0], v[j][1]) | ((unsigned long long)pk2(v[j][2], v[j][3]) << 32);
#pragma unroll
                    for (int e = 0; e < 4; ++e)
#pragma unroll
                        for (int c = 0; c < 8; ++c) z[c] += v[j][e] * wf[4 * j + e][c]; }
#pragma unroll
                for (int c = 0; c < 8; ++c) z[c] = wave_sum(z[c]);
                float zz = z[0];
#pragma unroll
                for (int c = 1; c < 8; ++c) zz = (lane == c) ? z[c] : zz;
                if (lane < 8) { const float t = zz + bfv; const float lf = fminf(t, 0.f) - log1pf(expf(-fabsf(t)));
                    if (m < MP) a.out[O_LFP + (size_t)m * 8 + lane] = lf; else a.out[O_LFS + (size_t)(m - MP) * 8 + lane] = lf; }
            }
        }
        for (int i = bx * 512 + tid; i < (MPAD - MTOT) * 1024 * 2 / 16; i += G * 512) ((v4u*)(XN + (size_t)MTOT * 1024))[i] = (v4u){0u, 0u, 0u, 0u};
    }
#endif
    xcd_barrier(bar);

#if PH & 2
    for (int rep_ = 0; rep_ < ((DUP & 2) ? 2 : 1); ++rep_) {
        FRESH_TID();
        if (bx < 192) {
            const bool smp = bx >= 128; const int bb = smp ? (bx - 128) >> 3 : bx >> 3, h = bx & 7; const int n = smp ? PAST + STOK : SEQ;
            float v[4];
#pragma unroll
            for (int e = 0; e < 4; ++e) { const int i = 4 * tid + e; float x = 0.f;
                if (i < n) { if (!smp) x = a.out[O_LFP + ((size_t)bb * SEQ + i) * 8 + h]; else x = i < PAST ? a.in[4][((size_t)bb * PAST + i) * 8 + h] : a.out[O_LFS + ((size_t)bb * STOK + (i - PAST)) * 8 + h]; }
                v[e] = x; }
            v[1] += v[0]; v[2] += v[1]; v[3] += v[2];
            const float tot = v[3]; float sc = tot;
#pragma unroll
            for (int o = 1; o < 64; o <<= 1) { const float t = __shfl_up(sc, o); if (lane >= o) sc += t; }
            LAS float* wt = (LAS float*)lds;
            if (lane == 63) wt[wave] = sc;
            __syncthreads();
            float base = sc - tot;
            for (int w = 0; w < wave; ++w) base += wt[w];
            float* dst = smp ? CBS + (size_t)(bb * 8 + h) * 1040 : CBP + (size_t)(bb * 8 + h) * SEQ;
#pragma unroll
            for (int e = 0; e < 4; ++e) { const int i = 4 * tid + e; if (i < n) dst[i] = -(base + v[e]) * LOG2E; }
        } else if (bx < 224) {
            const int idx = (bx - 192) * 512 + tid, h = idx >> 11, i = idx & 2047; TAB[idx] = i < 256 ? (a.in[10][h * 257 + i] - a.in[10][h * 257 + 256]) * LOG2E : 0.f;
        }
        __syncthreads();
        pg8::Gemm g{XN, Win_t, MP, NQKV, 1024}; pg8::StaticOrder S; S.init(MP, NQKV, G, bx);
        pg8::EpiQKV E{QKV, a.out};
        pg8::gemm_phase<pg8::EpiQKV, pg8::StaticOrder, true, true>(lds, g, S, E);
        for (int j = G - 1 - bx; j < NQKV / 32; j += G) s1_slab(j, XN, Win_t, QKV, a.out);
    }
#endif
    xcd_barrier(bar);

#if PH & 4
    for (int rep_ = 0; rep_ < ((DUP & 4) ? 2 : 1); ++rep_) {
        FRESH_TID();
        using abf = attn_body::bf16;
        const abf* Qb = (const abf*)QKV; abf* Ob = (abf*)XN;
        for (int v = vcu; v < 256; v += G) {
            const int pr = v >> 1, half = v & 1, b = pr >> 3, h = pr & 7;
            const float* cbg = CBP + (size_t)(b * 8 + h) * SEQ; const float* tbg = TAB + h * 2048;
            const unsigned long long sched = half ? 0x89FE12345ull : 0xDCBA067ull;
            const int nun = half ? 9 : 7;
            for (int i = 0; i < nun; ++i) { const int e = (int)((sched >> (4 * i)) & 15ull), qb = e & 7;
                if (e < 8) {
#if AM & 1
                    attn_body::attn_unit<0, 8>(b, h, qb, Qb, Qb + 512, Qb + 1024, Ob, SSQ, h, cbg, (char*)lds_raw);
#endif
                } else {
#if AM & 2
                    attn_body::attn_unit<1, 8>(b, h, qb, Qb + 1536, Qb + 2048, Qb + 2560, Ob + 512, SSQ, 8 + h, tbg, (char*)lds_raw);
#endif
                }
            }
#if AM & 4
            if (half == 0 && pr < 128) sample_attn_item(a, ws, lds, pr);
#endif
        }
    }
#endif
    xcd_barrier(bar);

#if PH & 8
    for (int rep_ = 0; rep_ < ((DUP & 8) ? 2 : 1); ++rep_) {
        FRESH_TID();
        pg8::Gemm g{XN, Wout_t, MP, 1024, 1024}; pg8::StaticOrder S; S.init(MP, 1024, G, bx);
        LAS float* tab = (LAS float*)(lds + TAB_OFF);
        pg8::Unit u;
        for (int i = 0; S.next(i, u); ++i) {
            if (tid < 256) { const f32x4* sp = (const f32x4*)(SSQ + (size_t)(u.pm * 256 + tid) * 16); const f32x4 s0 = sp[0], s1 = sp[1], s2 = sp[2], s3 = sp[3];
                const float qa = ((s0[0] + s0[1]) + (s0[2] + s0[3])) + ((s1[0] + s1[1]) + (s1[2] + s1[3])), qb = ((s2[0] + s2[1]) + (s2[2] + s2[3])) + ((s3[0] + s3[1]) + (s3[2] + s3[3]));
                const float ra = 1.0f / sqrtf(fabsf(qa) * (1.f / 512.f) + EPS), rb = 1.0f / sqrtf(fabsf(qb) * (1.f / 512.f) + EPS);
                tab[2 * tid] = ra / rb; tab[2 * tid + 1] = rb; }
            __syncthreads();
            pg8::EpiF32<true> E{MIX, 1024, tab};
            pg8::gemm_phase<pg8::EpiF32<true>, pg8::OneUnit, false, true>(lds, g, pg8::OneUnit{u}, E);
            __syncthreads();
        }
        if (rep_ == 0) for (int j = G - 1 - bx; j < 32; j += G) {
            s3_slab(j, XN, Wout_t, SSQ, MIXS);
            slab_rendezvous(ctl, 32u, tid);
            if (wave < 4) { const int r = 4 * j + wave;
                f32x4 g1[4], g2[4];
#pragma unroll
                for (int q = 0; q < 4; ++q) { g1[q] = ((const f32x4*)a.in[14])[64 * q + lane]; g2[q] = ((const f32x4*)a.in[15])[64 * q + lane]; }
                rowpass_mix(MIXS + (size_t)r * 1024, xs + (size_t)r * 1024, Y + (size_t)(MP + r) * 1024, XN2 + (size_t)(MP + r) * 1024, g1, g2, lane); }
        }
    }
#endif
    xcd_barrier(bar);

#if PH & 16
    for (int rep_ = 0; rep_ < ((DUP & 16) ? 2 : 1); ++rep_) {
        FRESH_TID();
        f32x4 g1[4], g2[4];
#pragma unroll
        for (int j = 0; j < 4; ++j) { g1[j] = ((const f32x4*)a.in[14])[64 * j + lane]; g2[j] = ((const f32x4*)a.in[15])[64 * j + lane]; }
        for (int m = gw; m < MP; m += NGW) rowpass_mix(MIX + (size_t)m * 1024, xp + (size_t)m * 1024, Y + (size_t)m * 1024, XN2 + (size_t)m * 1024, g1, g2, lane);
    }
#endif
    xcd_barrier(bar);

#if PH & 32
    for (int rep_ = 0; rep_ < ((DUP & 32) ? 2 : 1); ++rep_) {
        FRESH_TID();
        pg8::Gemm g{XN2, Wgu_t, MP, NGU, 1024}; pg8::StaticOrder S; S.init(MP, NGU, G, bx);
        pg8::EpiSwiGLU E{HB};
        pg8::gemm_phase<pg8::EpiSwiGLU, pg8::StaticOrder, true, true>(lds, g, S, E);
        for (int j = G - 1 - bx; j < DFF / 16; j += G) s4_slab(j, XN2, Wgu_t, HB);
    }
#endif
    xcd_barrier(bar);

#if PH & 64
    for (int rep_ = 0; rep_ < ((DUP & 64) ? 2 : 1); ++rep_) {
        FRESH_TID();
        pg8::Gemm g{HB, Wdn_t, MP, 1024, DFF}; pg8::StaticOrder S; S.init(MP, 1024, G, bx);
        pg8::EpiF32<false> E{FF, 1024, nullptr};
        pg8::gemm_phase<pg8::EpiF32<false>, pg8::StaticOrder, true, true>(lds, g, S, E);
        if (rep_ == 0) for (int j = G - 1 - bx; j < 32; j += G) {
            s5_slab(j, HB, Wdn_t, MIXS);
            slab_rendezvous(ctl + 64, 32u, tid);
            if (wave < 4) { const int r = 4 * j + wave;
                f32x4 g3[4];
#pragma unroll
                for (int q = 0; q < 4; ++q) g3[q] = ((const f32x4*)a.in[19])[64 * q + lane];
                rowpass_ff(MIXS + (size_t)r * 1024, Y + (size_t)(MP + r) * 1024, g3, lane); }
        }
    }
#endif
    xcd_barrier(bar);

#if PH & 128
    for (int rep_ = 0; rep_ < ((DUP & 128) ? 2 : 1); ++rep_) {
        FRESH_TID();
        f32x4 g3[4];
#pragma unroll
        for (int j = 0; j < 4; ++j) g3[j] = ((const f32x4*)a.in[19])[64 * j + lane];
        for (int m = gw; m < MP; m += NGW) rowpass_ff(FF + (size_t)m * 1024, Y + (size_t)m * 1024, g3, lane);
    }
#endif
}

extern "C" void kernel_launch(void* const* d_in, const int* in_sizes, int n_in, void* d_out, int out_size, void* d_ws, size_t ws_size, hipStream_t stream) {
    static int grid = 0;
    if (grid == 0) {
        if (n_in != 20 || out_size != (int)O_END || ws_size < WS_END) { fprintf(stderr, "kernel_launch: unexpected shapes (n_in %d, out %d, ws %zu)\n", n_in, out_size, ws_size); grid = -1; return; }
        int dev = 0, cus = 0, per_cu = 0;
        hipGetDevice(&dev); hipDeviceGetAttribute(&cus, hipDeviceAttributeMultiprocessorCount, dev);
        hipFuncSetAttribute((const void*)fwd_megakernel, hipFuncAttributeMaxDynamicSharedMemorySize, LDS_BYTES);
        hipOccupancyMaxActiveBlocksPerMultiprocessor(&per_cu, (const void*)fwd_megakernel, NWAVES * 64, LDS_BYTES);
        (void)hipGetLastError();
        if (per_cu < 1) { fprintf(stderr, "kernel_launch: occupancy query says %d blocks/CU\n", per_cu); per_cu = 1; }
        grid = cus;
    }
    if (grid < 0) return;
    if (hipMemsetAsync((char*)d_ws + WS_CTL, 0, 65536, stream) != hipSuccess) { fprintf(stderr, "kernel_launch: memset of the control words failed\n"); return; }
    Args a{};
    for (int i = 0; i < 20; ++i) a.in[i] = (const float*)d_in[i];
    a.out = (float*)d_out; a.ws = (unsigned char*)d_ws;
    void* args[] = {&a};
    hipError_t e = hipLaunchCooperativeKernel((const void*)fwd_megakernel, dim3(grid), dim3(NWAVES * 64), args, LDS_BYTES, stream);
    if (e != hipSuccess) fprintf(stderr, "cooperative launch failed: %s (grid %d)\n", hipGetErrorString(e), grid);
}
```

```cpp
#include <hip/hip_runtime.h>
#include <hip/hip_cooperative_groups.h>
#include <hip/hip_bf16.h>
#include <cstdio>
#include <cstdint>
#include <cmath>
namespace cg = cooperative_groups;

constexpr int DMODEL = 1024, NB = 16, SEQ = 2048, MP = NB * SEQ  , SBATCH = 8, STOK = 16, MS = SBATCH * STOK  ;
constexpr int MTOT = MP + MS  , MPAD = 33024  , PAST = 1024, BLEN = 512;
constexpr int DFF = 2816, DIN = 3080, NQKV = 3072, NGU = 2 * DFF;
constexpr float EPS = 1e-6f, LOG2E = 1.4426950408889634f;
constexpr float C2 = 0.125f * 1.4426950408889634f;
constexpr size_t O_Y = 0, O_AKP = 33685504, O_AVP = 50462720, O_LFP = 67239936, O_BKP = 67502080, O_BVP = 71696384,
                 O_AKS = 75890688, O_AVS = 75956224, O_LFS = 76021760, O_BKS = 76022784, O_BVS = 76088320, O_END = 76153856;
namespace pg8 {
#define PG8_LAS __attribute__((address_space(3)))
typedef unsigned short bf16_t;
typedef short bf16x8 __attribute__((ext_vector_type(8)));
typedef float f32x4 __attribute__((ext_vector_type(4)));
typedef unsigned u32x4 __attribute__((ext_vector_type(4)));
constexpr int BM = 256, BK = 64, HALF = 128, HTB = HALF * BK * 2  , STAGE_BYTES = 8 * HTB, NXCD = 8, WGM = 8;

__host__ __device__ __forceinline__ int lds_byte(int r, int c) { const int st = (r >> 4) * 2 + (c >> 5), rr = r & 15, cc = c & 31, ob = rr * 64 + cc * 2; return st * 1024 + (ob ^ (((ob >> 9) & 1) << 5)); }
__host__ __device__ __forceinline__ void stage_rc(int b, int& R, int& C) { const int st = b / 1024, sb = b % 1024, swz = sb ^ (((sb >> 9) & 1) << 5); R = (st >> 1) * 16 + swz / 64; C = (st & 1) * 32 + (swz % 64) / 2; }
__host__ __device__ __forceinline__ int perm32(int rho) { const int n = rho >> 4, i = rho & 15; return 8 * (i >> 2) + 4 * n + (i & 3); }

struct Unit { int pm, pn; };
struct Gemm { const bf16_t* A; const bf16_t* Bt; int M, N, K; };

struct StaticOrder {
    int nM, nN, nwg, G, c;
    __host__ __device__ void init(int M, int N, int G_, int c_) { nM = M / BM; nN = N / BM; nwg = nM * nN; G = G_; c = c_; }
    __host__ __device__ bool next(int i, Unit& u) const {
        const long L = (long)i * G + c; if (L >= nwg) return false;
        int wgid = (int)L; { const int q = nwg / NXCD, r = nwg % NXCD, xcd = wgid % NXCD, off = wgid / NXCD; wgid = (xcd < r ? xcd * (q + 1) : r * (q + 1) + (xcd - r) * q) + off; }
        const int nig = WGM * nN, gid = wgid / nig, fm = gid * WGM, gsz = (nM - fm) < WGM ? (nM - fm) : WGM;
        u.pm = fm + ((wgid % nig) % gsz); u.pn = (wgid % nig) / gsz; return true;
    }
    __device__ __forceinline__ void a_ready(const Unit&) const {}
    __device__ __forceinline__ void done(const Unit&) const {}
};

__device__ __forceinline__ unsigned cvt_pk_bf16(float lo, float hi) { unsigned r; asm volatile("v_cvt_pk_bf16_f32 %0, %1, %2" : "=v"(r) : "v"(lo), "v"(hi)); return r; }
struct OneUnit {
    Unit u;
    __device__ __forceinline__ bool next(int i, Unit& o) const { if (i) return false; o = u; return true; }
    __device__ __forceinline__ void a_ready(const Unit&) const {}
    __device__ __forceinline__ void done(const Unit&) const {}
};
typedef float f32x2 __attribute__((ext_vector_type(2)));
struct EpiQKV {
    static constexpr bool PERM = true, AFTER_DRAIN = false, HAS_MID = false; static constexpr int MID_T = -1;
    bf16_t* QKV; float* out;
    __device__ __forceinline__ void mid(f32x4 (&)[2][2][4][2], int, int) const {}
    __device__ __forceinline__ void operator()(const f32x4 (&acc)[2][2][4][2], const Unit& u, int wr, int wc, int fr, int fq) const {
        const int type = u.pn >> 1, colt = (u.pn & 1) * 256 + wc * 32 + 8 * fq;
        const float sc = (type == 0 || type == 3) ? C2 : 1.f;
        const bool sample = (u.pm == MP / 256);
        float* fb = nullptr;
        if (type == 1 || type == 2 || type == 4 || type == 5) {
            if (sample) fb = out + (type == 1 ? O_AKS : type == 2 ? O_AVS : type == 4 ? O_BKS : O_BVS);
            else if (type < 3) fb = out + (type == 1 ? O_AKP : O_AVP) + (size_t)u.pm * 256 * 512;
            else { const int bt = u.pm & 7; if (bt >= 6) fb = out + (type == 4 ? O_BKP : O_BVP) + ((size_t)(u.pm >> 3) * 512 + (size_t)(bt - 6) * 256) * 512; }
        }
#pragma unroll
        for (int ai = 0; ai < 2; ++ai) {
            if (sample && ai == 1) break;
#pragma unroll
            for (int m = 0; m < 4; ++m) { const int rl = ai * HALF + wr * 64 + m * 16 + fr;
                bf16_t* rowp = QKV + (size_t)(u.pm * BM + rl) * NQKV + u.pn * BM + wc * 32 + 8 * fq;
#pragma unroll
                for (int bj = 0; bj < 2; ++bj) { f32x4 v0 = acc[ai][bj][m][0], v1 = acc[ai][bj][m][1];
                    if (fb) { float* fp = fb + (size_t)rl * 512 + colt + bj * HALF; *(f32x4*)fp = v0; *(f32x4*)(fp + 4) = v1; }
                    v0 = v0 * sc; v1 = v1 * sc; u32x4 w; w.x = cvt_pk_bf16(v0[0], v0[1]); w.y = cvt_pk_bf16(v0[2], v0[3]); w.z = cvt_pk_bf16(v1[0], v1[1]); w.w = cvt_pk_bf16(v1[2], v1[3]);
                    *(u32x4*)(rowp + bj * HALF) = w; } }
        }
    }
};
struct EpiSwiGLU {
    static constexpr bool PERM = true, AFTER_DRAIN = false, HAS_MID = false; static constexpr int MID_T = -1;
    bf16_t* H;
    __device__ __forceinline__ void mid(f32x4 (&)[2][2][4][2], int, int) const {}
    __device__ __forceinline__ void operator()(const f32x4 (&acc)[2][2][4][2], const Unit& u, int wr, int wc, int fr, int fq) const {
#pragma unroll
        for (int ai = 0; ai < 2; ++ai)
#pragma unroll
            for (int m = 0; m < 4; ++m) { const int row = u.pm * BM + ai * HALF + wr * 64 + m * 16 + fr;
                float hv[8];
#pragma unroll
                for (int n = 0; n < 2; ++n)
#pragma unroll
                    for (int e = 0; e < 4; ++e) { const float g = acc[ai][0][m][n][e], up = acc[ai][1][m][n][e];
                        hv[4 * n + e] = g * up * __builtin_amdgcn_rcpf(1.0f + __builtin_amdgcn_exp2f(-g * LOG2E)); }
                u32x4 w; w.x = cvt_pk_bf16(hv[0], hv[1]); w.y = cvt_pk_bf16(hv[2], hv[3]); w.z = cvt_pk_bf16(hv[4], hv[5]); w.w = cvt_pk_bf16(hv[6], hv[7]);
                *(u32x4*)(H + (size_t)row * DFF + u.pn * HALF + wc * 32 + 8 * fq) = w; }
    }
};
template <bool MID> struct EpiF32 {
    static constexpr bool PERM = false, AFTER_DRAIN = false, HAS_MID = MID; static constexpr int MID_T = 8;
    float* F; int ldc; const PG8_LAS float* tab;
    __device__ __forceinline__ void mid(f32x4 (&acc)[2][2][4][2], int wr, int fr) const {
#pragma unroll
        for (int ai = 0; ai < 2; ++ai)
#pragma unroll
            for (int m = 0; m < 4; ++m) { const float s = tab[(ai * HALF + wr * 64 + m * 16 + fr) * 2];
#pragma unroll
                for (int bj = 0; bj < 2; ++bj)
#pragma unroll
                    for (int n = 0; n < 2; ++n) acc[ai][bj][m][n] = acc[ai][bj][m][n] * s; }
    }
    __device__ __forceinline__ void operator()(const f32x4 (&acc)[2][2][4][2], const Unit& u, int wr, int wc, int fr, int fq) const {
        const int col0 = u.pn * BM + wc * 32 + 4 * fq;
#pragma unroll
        for (int ai = 0; ai < 2; ++ai)
#pragma unroll
            for (int m = 0; m < 4; ++m) { const int rl = ai * HALF + wr * 64 + m * 16 + fr; const float s = MID ? tab[rl * 2 + 1] : 1.f;
                float* rowp = F + (size_t)(u.pm * BM + rl) * ldc + col0;
#pragma unroll
                for (int bj = 0; bj < 2; ++bj)
#pragma unroll
                    for (int n = 0; n < 2; ++n) *(f32x4*)(rowp + bj * HALF + n * 16) = acc[ai][bj][m][n] * s; }
    }
};

template <class Epi, class Sched, bool ALIGN_EPI = false, bool SP2 = false>
__device__ __forceinline__ void gemm_phase(PG8_LAS unsigned char* lds, const Gemm g, const Sched& S, const Epi& E) {
    int tid_ = threadIdx.x; asm volatile("" : "+v"(tid_));
    const int tid = tid_, wid = __builtin_amdgcn_readfirstlane(tid >> 6), lane = tid & 63, wr = wid >> 2, wc = wid & 3, fr = lane & 15, fq = lane >> 4;
    const int K = g.K, nt = K / BK;
    unsigned voffA[2], voffB[2];
#pragma unroll
    for (int i = 0; i < 2; ++i) { int R, C; stage_rc(tid * 16 + i * 8192, R, C); const int Rb = Epi::PERM ? ((R & ~31) + perm32(R & 31)) : R;
        voffA[i] = (unsigned)(R * K + C) * 2u; voffB[i] = (unsigned)(Rb * K + C) * 2u; }
    const size_t kstep = (size_t)(BK * 2);
    const size_t hstep = (size_t)HALF * K * 2;
    const size_t tstep = 2 * hstep;
    const unsigned ldsw = (unsigned)wid * 1024u;
    const int aoff = lds_byte(wr * 64 + fr, fq * 8), boff = lds_byte(wc * 32 + fr, fq * 8);
#define PG8_SA(b, h) (((b) * 2 + (h)) * HTB)
#define PG8_SB(b, h) ((4 + (b) * 2 + (h)) * HTB)
#define PG8_STAGE(bufoff, gbase, voff) do { _Pragma("unroll") for (int _i = 0; _i < 2; ++_i) \
        __builtin_amdgcn_global_load_lds((const unsigned*)((const char*)(gbase) + (voff)[_i]), (PG8_LAS unsigned*)(lds + (bufoff) + ldsw + _i * 8192), 16, 0, 0); } while (0)
#define PG8_LDA(dst, b, h) do { _Pragma("unroll") for (int m = 0; m < 4; ++m) _Pragma("unroll") for (int k = 0; k < 2; ++k) dst[m][k] = *(const PG8_LAS bf16x8*)(lds + PG8_SA(b, h) + aoff + m * 2048 + k * 1024); } while (0)
#define PG8_LDB(dst, b, h) do { _Pragma("unroll") for (int n = 0; n < 2; ++n) _Pragma("unroll") for (int k = 0; k < 2; ++k) dst[n][k] = *(const PG8_LAS bf16x8*)(lds + PG8_SB(b, h) + boff + n * 2048 + k * 1024); } while (0)
#define PG8_MMA(ai, bj, At, Bt) do { __builtin_amdgcn_s_setprio(1); _Pragma("unroll") for (int m = 0; m < 4; ++m) _Pragma("unroll") for (int n = 0; n < 2; ++n) _Pragma("unroll") for (int k = 0; k < 2; ++k) \
        acc[ai][bj][m][n] = __builtin_amdgcn_mfma_f32_16x16x32_bf16(Bt[n][k], At[m][k], acc[ai][bj][m][n], 0, 0, 0); __builtin_amdgcn_s_setprio(0); } while (0)
#define PG8_WAIT_V(n) asm volatile("s_waitcnt vmcnt(" #n ")" ::: "memory")
#define PG8_WAIT_L(n) asm volatile("s_waitcnt lgkmcnt(" #n ")" ::: "memory")
#define PG8_BAR __builtin_amdgcn_s_barrier()
#define PG8_SCHED __builtin_amdgcn_sched_barrier(0)
    Unit cur, nxt; int ui = 0;
    if (!S.next(0, cur)) return;
    f32x4 acc[2][2][4][2];
#pragma unroll
    for (int a = 0; a < 2; ++a)
#pragma unroll
        for (int b = 0; b < 2; ++b)
#pragma unroll
            for (int m = 0; m < 4; ++m)
#pragma unroll
                for (int n = 0; n < 2; ++n) acc[a][b][m][n] = (f32x4){0.f, 0.f, 0.f, 0.f};
    bf16x8 At[4][2], B0[2][2], B1[2][2];
    const char* cA = (const char*)g.A + (size_t)cur.pm * tstep; const char* cB = (const char*)g.Bt + (size_t)cur.pn * tstep;
    S.a_ready(cur);
    if constexpr (SP2) {
        PG8_STAGE(PG8_SB(0, 0), cB, voffB); PG8_STAGE(PG8_SB(0, 1), cB + hstep, voffB); PG8_STAGE(PG8_SA(0, 0), cA, voffA); PG8_STAGE(PG8_SA(0, 1), cA + hstep, voffA);
        if (wr == 1) PG8_BAR;
        PG8_WAIT_V(2); PG8_BAR;
        PG8_STAGE(PG8_SB(1, 0), cB + kstep, voffB); PG8_STAGE(PG8_SA(1, 0), cA + kstep, voffA); PG8_STAGE(PG8_SB(1, 1), cB + hstep + kstep, voffB);
        PG8_WAIT_V(6); PG8_BAR;
    } else {
        PG8_STAGE(PG8_SB(0, 0), cB, voffB); PG8_STAGE(PG8_SA(0, 0), cA, voffA); PG8_STAGE(PG8_SB(0, 1), cB + hstep, voffB); PG8_STAGE(PG8_SA(0, 1), cA + hstep, voffA);
        if (wr == 1) PG8_BAR;
        PG8_WAIT_V(4); PG8_BAR;
        PG8_STAGE(PG8_SB(1, 0), cB + kstep, voffB); PG8_STAGE(PG8_SA(1, 0), cA + kstep, voffA); PG8_STAGE(PG8_SB(1, 1), cB + hstep + kstep, voffB);
        PG8_WAIT_V(6); PG8_BAR;
    }
    for (;;) {
        const bool has_next = S.next(ui + 1, nxt);
        const char* nA = has_next ? (const char*)g.A + (size_t)nxt.pm * tstep : cA; const char* nB = has_next ? (const char*)g.Bt + (size_t)nxt.pn * tstep : cB;
        for (int t = 0; t < nt; t += 2) {
            const bool last = (t == nt - 2);
            if constexpr (Epi::HAS_MID) { if (t == Epi::MID_T) E.mid(acc, wr, fr); }
            const char* a1 = cA + (size_t)(t + 1) * kstep;
            const char* a2 = last ? nA : cA + (size_t)(t + 2) * kstep; const char* b2 = last ? nB : cB + (size_t)(t + 2) * kstep;
            const char* a3 = a2 + kstep; const char* b3 = b2 + kstep;
            if (last && has_next) S.a_ready(nxt);
            if constexpr (SP2) {
            PG8_LDB(B0, 0, 0); PG8_LDB(B1, 0, 1); PG8_SCHED; PG8_LDA(At, 0, 0); PG8_STAGE(PG8_SA(1, 1), a1 + hstep, voffA);
            PG8_WAIT_V(8); PG8_WAIT_L(0); PG8_BAR; PG8_MMA(0, 0, At, B0); PG8_MMA(0, 1, At, B1); PG8_BAR; PG8_SCHED;
            PG8_LDA(At, 0, 1); PG8_STAGE(PG8_SB(0, 0), b2, voffB); PG8_STAGE(PG8_SB(0, 1), b2 + hstep, voffB); PG8_STAGE(PG8_SA(0, 0), a2, voffA);
            PG8_WAIT_V(8); PG8_WAIT_L(0); PG8_BAR; PG8_MMA(1, 0, At, B0); PG8_MMA(1, 1, At, B1); PG8_BAR; PG8_SCHED;
            PG8_LDB(B0, 1, 0); PG8_LDB(B1, 1, 1); PG8_SCHED; PG8_LDA(At, 1, 0); PG8_STAGE(PG8_SA(0, 1), a2 + hstep, voffA);
            PG8_WAIT_V(8); PG8_WAIT_L(0); PG8_BAR; PG8_MMA(0, 0, At, B0); PG8_MMA(0, 1, At, B1); PG8_BAR; PG8_SCHED;
            PG8_LDA(At, 1, 1); PG8_STAGE(PG8_SB(1, 0), b3, voffB); PG8_STAGE(PG8_SB(1, 1), b3 + hstep, voffB); PG8_STAGE(PG8_SA(1, 0), a3, voffA);
            PG8_WAIT_V(8); PG8_WAIT_L(0); PG8_BAR; PG8_MMA(1, 0, At, B0); PG8_MMA(1, 1, At, B1); PG8_BAR; PG8_SCHED;
            } else {
            PG8_LDB(B0, 0, 0); PG8_SCHED; PG8_LDA(At, 0, 0); PG8_STAGE(PG8_SA(1, 1), a1 + hstep, voffA);
            PG8_WAIT_L(8); PG8_BAR; PG8_WAIT_L(0); PG8_MMA(0, 0, At, B0); PG8_BAR; PG8_SCHED;
            PG8_LDB(B1, 0, 1); PG8_STAGE(PG8_SB(0, 0), b2, voffB);
            PG8_BAR; PG8_WAIT_L(0); PG8_MMA(0, 1, At, B1); PG8_BAR;
            PG8_LDA(At, 0, 1); PG8_STAGE(PG8_SA(0, 0), a2, voffA);
            PG8_BAR; PG8_WAIT_L(0); PG8_MMA(1, 0, At, B0); PG8_BAR; PG8_SCHED;
            PG8_STAGE(PG8_SB(0, 1), b2 + hstep, voffB);
            PG8_WAIT_V(6); PG8_BAR; PG8_MMA(1, 1, At, B1); PG8_BAR;
            PG8_LDB(B0, 1, 0); PG8_SCHED; PG8_LDA(At, 1, 0); PG8_STAGE(PG8_SA(0, 1), a2 + hstep, voffA);
            PG8_WAIT_L(8); PG8_BAR; PG8_WAIT_L(0); PG8_MMA(0, 0, At, B0); PG8_BAR; PG8_SCHED;
            PG8_LDB(B1, 1, 1); PG8_STAGE(PG8_SB(1, 0), b3, voffB);
            PG8_BAR; PG8_WAIT_L(0); PG8_MMA(0, 1, At, B1); PG8_BAR;
            PG8_LDA(At, 1, 1); PG8_STAGE(PG8_SA(1, 0), a3, voffA);
            PG8_BAR; PG8_WAIT_L(0); PG8_MMA(1, 0, At, B0); PG8_BAR; PG8_SCHED;
            PG8_STAGE(PG8_SB(1, 1), b3 + hstep, voffB);
            PG8_WAIT_V(6); PG8_BAR; PG8_MMA(1, 1, At, B1); PG8_BAR;
            }
        }
        if constexpr (ALIGN_EPI) { if (wr == 0) PG8_BAR; }
        if constexpr (!Epi::AFTER_DRAIN) { E(acc, cur, wr, wc, fr, fq); S.done(cur); }
        if (!has_next) break;
#pragma unroll
        for (int a = 0; a < 2; ++a)
#pragma unroll
            for (int b = 0; b < 2; ++b)
#pragma unroll
                for (int m = 0; m < 4; ++m)
#pragma unroll
                    for (int n = 0; n < 2; ++n) acc[a][b][m][n] = (f32x4){0.f, 0.f, 0.f, 0.f};
        cur = nxt; cA = nA; cB = nB; ++ui;
        if constexpr (ALIGN_EPI) { if (wr == 1) PG8_BAR; }
    }
    PG8_WAIT_V(0);
    if constexpr (!ALIGN_EPI) { if (wr == 0) PG8_BAR; }
    PG8_BAR;
    if constexpr (Epi::AFTER_DRAIN) { E.fused(acc, cur, wr, wc, fr, fq, lds, wid, lane); S.done(cur); }
#undef PG8_SA
#undef PG8_SB
#undef PG8_STAGE
#undef PG8_LDA
#undef PG8_LDB
#undef PG8_MMA
#undef PG8_WAIT_V
#undef PG8_WAIT_L
#undef PG8_BAR
#undef PG8_SCHED
}
}
#include <hip/hip_bf16.h>
#include <cmath>
#ifndef NOPOST
#define NOPOST 0
#endif
#ifndef NOSSQ
#define NOSSQ 0
#endif
namespace attn_body {
using bf16=__hip_bfloat16;
using bf16x8=__attribute__((ext_vector_type(8)))short;
using s16x4=__attribute__((ext_vector_type(4)))short;
using f32x16=__attribute__((ext_vector_type(16)))float;
using u32x4=__attribute__((ext_vector_type(4)))unsigned;
constexpr int SEQ=2048,D=64,DM=3072,DMO=1024;
constexpr int NW=8,QBLK=32,QB=QBLK*NW,KVBLK=64,NQB=SEQ/QB;
constexpr int ATTN_PITCH=DM, ATTN_UNIT_ROWS=QB;
__device__ __forceinline__ int crow(int r,int hi){return (r&3)+8*(r>>2)+4*hi;}
#define SBAR() __builtin_amdgcn_sched_barrier(0)
__device__ __forceinline__ void cmask(f32x16&p0,f32x16&p1,int jb,int qrel,int hi){
  const float NEG=-INFINITY; int kb=64*jb+4*hi;
  #pragma unroll
  for(int r=0;r<16;++r){int kv=kb+(r&3)+8*(r>>2); if(kv>qrel)p0[r]=NEG; if(kv+32>qrel)p1[r]=NEG;}
}

constexpr int NSLOT=3, SLOTB=8192;
constexpr int LDS_K=0, LDS_V=NSLOT*SLOTB, LDS_WS=2*NSLOT*SLOTB, LDS_OST=LDS_WS+NW*64*4, LDS_BYTES=LDS_OST+NW*4096, LDS_CB=LDS_BYTES, LDS_TOTAL=LDS_CB+8192;
constexpr float C2=0.125f*1.4426950408889634f;
__device__ __forceinline__ void glds16(const void*gsrc,unsigned lds_dst){unsigned keep;
  asm volatile("s_mov_b32 %0, m0\n\ts_mov_b32 m0, %2\n\ts_nop 0\n\tglobal_load_lds_dwordx4 %1, off\n\ts_mov_b32 m0, %0":"=&s"(keep):"v"(gsrc),"s"(lds_dst):"memory");}
__device__ __forceinline__ float max3f(float a,float b,float c){float r;asm("v_max3_f32 %0, %1, %2, %3":"=v"(r):"v"(a),"v"(b),"v"(c));return r;}
__device__ __forceinline__ float max2f(float a,float b){float r;asm("v_max_f32_e32 %0, %1, %2":"=v"(r):"v"(a),"v"(b));return r;}
__device__ __forceinline__ float fadd_s(float a,float b){float r;asm("v_add_f32_e32 %0, %1, %2":"=v"(r):"v"(a),"v"(b));return r;}
__device__ __forceinline__ float fsub_s(float a,float b){float r;asm("v_sub_f32_e32 %0, %1, %2":"=v"(r):"v"(a),"v"(b));return r;}
typedef float f32x2_t __attribute__((ext_vector_type(2))); typedef __bf16 bf16x2_t __attribute__((ext_vector_type(2)));
__device__ __forceinline__ unsigned cvtpk_s(float lo,float hi){f32x2_t v={lo,hi};bf16x2_t b=__builtin_convertvector(v,bf16x2_t);return __builtin_bit_cast(unsigned,b);}
#define WAIT_BAR(N) asm volatile("s_waitcnt vmcnt(" #N ") lgkmcnt(0)\n\ts_barrier":::"memory")

__device__ __forceinline__ void qkt(f32x16&p0,f32x16&p1,const char*Kslot,const bf16x8*qr,const f32x16&negm,int r32,int hi){
  const char*kb=Kslot+hi*1024+r32*16;
  #pragma unroll
  for(int d0=0;d0<4;++d0){
    const bf16x8 b0=*reinterpret_cast<const bf16x8*>(kb+d0*2048);
    const bf16x8 b1=*reinterpret_cast<const bf16x8*>(kb+d0*2048+512);
    if(d0==0){p0=__builtin_amdgcn_mfma_f32_32x32x16_bf16(b0,qr[0],negm,0,0,0);p1=__builtin_amdgcn_mfma_f32_32x32x16_bf16(b1,qr[0],negm,0,0,0);}
    else{p0=__builtin_amdgcn_mfma_f32_32x32x16_bf16(b0,qr[d0],p0,0,0,0);p1=__builtin_amdgcn_mfma_f32_32x32x16_bf16(b1,qr[d0],p1,0,0,0);}}
}
typedef __attribute__((address_space(3))) const char* lds_cptr;
typedef short v4i16_t __attribute__((ext_vector_type(4)));
__device__ __forceinline__ void kload8(bf16x8*kf,lds_cptr kp){
  kf[0]=*(const __attribute__((address_space(3))) bf16x8*)(kp);      kf[1]=*(const __attribute__((address_space(3))) bf16x8*)(kp+512);
  kf[2]=*(const __attribute__((address_space(3))) bf16x8*)(kp+2048); kf[3]=*(const __attribute__((address_space(3))) bf16x8*)(kp+2560);
  kf[4]=*(const __attribute__((address_space(3))) bf16x8*)(kp+4096); kf[5]=*(const __attribute__((address_space(3))) bf16x8*)(kp+4608);
  kf[6]=*(const __attribute__((address_space(3))) bf16x8*)(kp+6144); kf[7]=*(const __attribute__((address_space(3))) bf16x8*)(kp+6656);
}
__device__ __forceinline__ void kload2(bf16x8*kf,lds_cptr kp,int j){ kf[2*j]=*(const __attribute__((address_space(3))) bf16x8*)(kp+j*2048); kf[2*j+1]=*(const __attribute__((address_space(3))) bf16x8*)(kp+j*2048+512); }
__device__ __forceinline__ s16x4 vtr(lds_cptr p){ return __builtin_bit_cast(s16x4,__builtin_amdgcn_ds_read_tr16_b64_v4i16((__attribute__((address_space(3))) v4i16_t*)p)); }
__device__ __forceinline__ float rowmax(const f32x16&p0,const f32x16&p1){
  float a=max3f(p0[0],p0[1],p1[0]),b=max3f(p0[2],p0[3],p1[1]);a=max3f(a,p1[2],p1[3]);
  #pragma unroll
  for(int r=4;r<16;r+=4){a=max3f(a,p0[r],p0[r+1]);b=max3f(b,p0[r+2],p0[r+3]);a=max3f(a,p1[r],p1[r+1]);b=max3f(b,p1[r+2],p1[r+3]);}
  const float m=max2f(a,b);
  auto rr=__builtin_amdgcn_permlane32_swap(__float_as_uint(m),__float_as_uint(m),false,false);
  return max2f(__uint_as_float(rr[0]),__uint_as_float(rr[1]));
}
__device__ __forceinline__ void pv(f32x16*o,int vb,bf16x8 pa0,bf16x8 pa1,bf16x8 pa2,bf16x8 pa3){
  #pragma unroll
  for(int d0=0;d0<2;++d0){s16x4 lo[4],hi[4];
    #pragma unroll
    for(int ks=0;ks<4;++ks){
      asm volatile("ds_read_b64_tr_b16 %0,%1 offset:%c2":"=&v"(lo[ks]):"v"(vb),"i"(d0*4096+ks*1024):"memory");
      asm volatile("ds_read_b64_tr_b16 %0,%1 offset:%c2":"=&v"(hi[ks]):"v"(vb),"i"(d0*4096+ks*1024+512):"memory");}
    asm volatile("s_waitcnt lgkmcnt(0)":::"memory");SBAR();
    #define PK(k) (bf16x8){lo[k][0],lo[k][1],lo[k][2],lo[k][3],hi[k][0],hi[k][1],hi[k][2],hi[k][3]}
    o[d0]=__builtin_amdgcn_mfma_f32_32x32x16_bf16(pa0,PK(0),o[d0],0,0,0);
    o[d0]=__builtin_amdgcn_mfma_f32_32x32x16_bf16(pa1,PK(1),o[d0],0,0,0);
    o[d0]=__builtin_amdgcn_mfma_f32_32x32x16_bf16(pa2,PK(2),o[d0],0,0,0);
    o[d0]=__builtin_amdgcn_mfma_f32_32x32x16_bf16(pa3,PK(3),o[d0],0,0,0);
    #undef PK
  }
}

#ifndef ATTN_STORE16
#define ATTN_STORE16(p,v) (*(u32x4*)(p)=(v))
#endif
template<int MODE,int THRL> __device__ __forceinline__ void attn_unit(int b,int h,int qb,const bf16*Q,const bf16*__restrict__ K,const bf16*__restrict__ V,bf16*O,float*SSQ,int hidx,const float*cbg,char*shm){
  int tid_=threadIdx.x; asm volatile("":"+v"(tid_));
  const int tid=tid_,lane=tid&63,r32=lane&31,hi=lane>>5; const int wid=__builtin_amdgcn_readfirstlane(tid>>6);
  const long rowbase=(long)b*SEQ; const int q0=qb*QB; const int tlo=(MODE==1)?((4*qb-8)>0?(4*qb-8):0):0;
  const bf16*Qw=Q+(rowbase+q0+wid*QBLK)*DM+h*D;
  const bf16*Kh=K+(rowbase+tlo*KVBLK)*DM+h*D,*Vh=V+(rowbase+tlo*KVBLK)*DM+h*D;
  const unsigned lds0=(unsigned)(uintptr_t)shm;
  float*wsf=(float*)(shm+LDS_WS)+wid*64;
  const bf16*ksrc=Kh+(long)lane*DM+wid*8;
  const bf16*vsrc=Vh+(long)(16*(wid&3)+(lane>>2))*DM+(wid>>2)*32+(lane&3)*8;
  const unsigned kdst=lds0+LDS_K+wid*1024, vdst=lds0+LDS_V+wid*1024;
  #define DMA_K(t,slot) glds16(ksrc+(long)(t)*KVBLK*DM,(unsigned)__builtin_amdgcn_readfirstlane(kdst+(slot)))
  #define DMA_V(t,slot) glds16(vsrc+(long)(t)*KVBLK*DM,(unsigned)__builtin_amdgcn_readfirstlane(vdst+(slot)))
  const int vb0=(int)(lds0+LDS_V)+((lane>>4)&1)*32+(lane&3)*8+(4*hi+((lane&15)>>2))*64;
  const char*Kbase=shm+LDS_K; bf16x8 kf[8];
  const lds_cptr shm3=(lds_cptr)shm; const lds_cptr kp0=shm3+LDS_K+hi*1024+r32*16; const lds_cptr vp0=shm3+LDS_V+((lane>>4)&1)*32+(lane&3)*8+(4*hi+((lane&15)>>2))*64;
  const int NT=(q0+QB)/KVBLK-tlo;
  glds16(cbg+wid*256+lane*4,(unsigned)__builtin_amdgcn_readfirstlane(lds0+LDS_CB+wid*1024));
  DMA_K(0,0);DMA_V(0,0);DMA_K(1,SLOTB);
  bf16x8 qr[4];
  #pragma unroll
  for(int d0=0;d0<4;++d0)qr[d0]=*reinterpret_cast<const bf16x8*>(&Qw[(long)r32*DM+d0*16+hi*8]);
  float mhat=0.f,l_reg=0.f;f32x16 o[2];o[0]=f32x16{};o[1]=f32x16{};f32x16 negm=f32x16{};asm volatile("":"+v"(negm));
  const int qrel=wid*QBLK+r32;
  typedef __attribute__((address_space(3))) const float* lds_fptr; typedef float f32x4a __attribute__((ext_vector_type(4)));
  const lds_fptr cb3=(lds_fptr)(shm3+LDS_CB); const float NEGB=-8192.f;
  const int cw=4*qb+(wid>>1);
  const int qabs=q0+wid*QBLK+r32;
  #define CMASK(P0,P1,t) do{int jb_=(t)-(NT-4); if(MODE==0&&jb_>=0)cmask(P0,P1,jb_,qrel,hi);}while(0)
  #define POST(P0,P1,t) do{ if(NOPOST){} else \
    if(MODE==0){ const lds_fptr cp_=cb3+(t)*64+4*hi; \
      _Pragma("unroll") for(int g_=0;g_<4;++g_){ const f32x4a a_=*(const __attribute__((address_space(3))) f32x4a*)(cp_+8*g_); const f32x4a b_=*(const __attribute__((address_space(3))) f32x4a*)(cp_+32+8*g_); \
        _Pragma("unroll") for(int i_=0;i_<4;++i_){P0[4*g_+i_]+=a_[i_];P1[4*g_+i_]+=b_[i_];} } \
    } else { const int tabs_=tlo+(t); const int j_=cw-tabs_; \
      if(j_<0||j_>8){ _Pragma("unroll") for(int r_=0;r_<16;++r_){P0[r_]=NEGB;P1[r_]=NEGB;} } \
      else if(j_<=2){ const int base_=qabs-64*tabs_-4*hi; \
        _Pragma("unroll") for(int r_=0;r_<16;++r_){ const int d0_=base_-((r_&3)+8*(r_>>2)); const int i0_=(d0_<128?d0_:128)+128; const int d1_=d0_-32; const int i1_=(d1_<128?d1_:128)+128; \
          P0[r_]+=cb3[i0_]; P1[r_]+=cb3[i1_]; } } \
    } }while(0)
  bool resc=false;
  #define START(P0,P1) do{ const float rm=rowmax(P0,P1); resc=false; \
    { const float dl=rm; mhat=fadd_s(mhat,dl); \
      _Pragma("unroll") for(int r=0;r<16;++r){P0[r]=fsub_s(P0[r],dl);P1[r]=fsub_s(P1[r],dl);} \
      _Pragma("unroll") for(int r=0;r<16;++r)negm[r]=-mhat; asm volatile("":"+v"(negm)); } \
    _Pragma("unroll") for(int r=0;r<16;++r)P0[r]=__builtin_amdgcn_exp2f(P0[r]); }while(0)
  #define RESC() do{ if(resc){ asm volatile("s_waitcnt lgkmcnt(0)":::"memory"); \
      _Pragma("unroll") for(int d_=0;d_<2;++d_) _Pragma("unroll") for(int r=0;r<16;++r)o[d_][r]*=wsf[crow(r,hi)]; } }while(0)
  f32x16 pA0,pA1,pB0,pB1;
  int sl_prev=0,sl_cur=0,sl_next=SLOTB;
  #define ROT() do{sl_prev=sl_cur;sl_cur=sl_next;sl_next=(sl_next==(NSLOT-1)*SLOTB)?0:sl_next+SLOTB;}while(0)
  DMA_K(2,2*SLOTB);
  WAIT_BAR(3);
  qkt(pA0,pA1,Kbase,qr,negm,r32,hi);asm volatile("s_nop 15\n\ts_nop 7":"+v"(pA0),"+v"(pA1));POST(pA0,pA1,0);CMASK(pA0,pA1,0);
  START(pA0,pA1);
  _Pragma("unroll") for(int r=0;r<16;++r)pA1[r]=__builtin_amdgcn_exp2f(pA1[r]);
  WAIT_BAR(0);
  DMA_K(3,0);DMA_V(1,SLOTB);
  ROT();
  kload8(kf,kp0+sl_cur);
  WAIT_BAR(2);
  s16x4 vlo[8],vhi[8]; u32x4 pw0,pw1,pw2,pw3;
  #define PKW(P,B) cvtpk_s(P[B],P[B+1])
  #define PAF(k) __builtin_bit_cast(bf16x8,pw##k)
  #define VFR(i) (bf16x8){vlo[i][0],vlo[i][1],vlo[i][2],vlo[i][3],vhi[i][0],vhi[i][1],vhi[i][2],vhi[i][3]}
  #define PIN(x) asm volatile("":"+v"(x))
  #define MX3(a,b,c) __builtin_fmaxf(__builtin_fmaxf((a),(b)),(c))
  #define GAPA(MF,A0,A1,A2,A3,W0,W1,PW) do{ MF; sacc+=A0; sacc+=A1; sacc+=A2; sacc+=A3; PIN(sacc); W0; W1; PIN(PW); SBAR(); }while(0)
  #define EX(v) __builtin_amdgcn_exp2f(v)
  #define GAPB(MF,X,B) do{ MF; X[B]=EX(X[B]); X[B+1]=EX(X[B+1]); X[B+2]=EX(X[B+2]); X[B+3]=EX(X[B+3]); PIN(X); SBAR(); }while(0)
  #define VRD(i) do{ vlo[i]=vtr(vp_+(((i)>>2)*4096+((i)&3)*1024)); vhi[i]=vtr(vp_+(((i)>>2)*4096+((i)&3)*1024+512)); }while(0)
  #define KRD(G,j) do{ if(G){ kload2(kf,kp0+sl_next,j); SBAR(); } }while(0)
  #define STEP(C0,C1,P0,P1,t,GK,GV,GL) do{ SBAR(); \
    const lds_cptr vp_=vp0+sl_prev; \
    VRD(0); SBAR(); float sacc=(P0[0]+P0[1]); \
    GAPA(C0=__builtin_amdgcn_mfma_f32_32x32x16_bf16(kf[0],qr[0],negm,0,0,0), P0[2],P0[3],P0[4],P0[5],     pw0[0]=PKW(P0,0), pw0[1]=PKW(P0,2), pw0); \
    VRD(4); SBAR(); GAPA(C1=__builtin_amdgcn_mfma_f32_32x32x16_bf16(kf[1],qr[0],negm,0,0,0), P0[6],P0[7],P0[8],P0[9],     pw0[2]=PKW(P0,4), pw0[3]=PKW(P0,6), pw0); \
    VRD(1); SBAR(); GAPA(C0=__builtin_amdgcn_mfma_f32_32x32x16_bf16(kf[2],qr[1],C0,0,0,0),   P0[10],P0[11],P0[12],P0[13], pw1[0]=PKW(P0,8), pw1[1]=PKW(P0,10), pw1); \
    VRD(5); SBAR(); GAPA(C1=__builtin_amdgcn_mfma_f32_32x32x16_bf16(kf[3],qr[1],C1,0,0,0),   P0[14],P0[15],P1[0],P1[1],   pw1[2]=PKW(P0,12),pw1[3]=PKW(P0,14), pw1); \
    VRD(2); SBAR(); GAPA(C0=__builtin_amdgcn_mfma_f32_32x32x16_bf16(kf[4],qr[2],C0,0,0,0),   P1[2],P1[3],P1[4],P1[5],     pw2[0]=PKW(P1,0), pw2[1]=PKW(P1,2), pw2); \
    VRD(6); SBAR(); GAPA(C1=__builtin_amdgcn_mfma_f32_32x32x16_bf16(kf[5],qr[2],C1,0,0,0),   P1[6],P1[7],P1[8],P1[9],     pw2[2]=PKW(P1,4), pw2[3]=PKW(P1,6), pw2); \
    VRD(3); SBAR(); GAPA(C0=__builtin_amdgcn_mfma_f32_32x32x16_bf16(kf[6],qr[3],C0,0,0,0),   P1[10],P1[11],P1[12],P1[13], pw3[0]=PKW(P1,8), pw3[1]=PKW(P1,10), pw3); \
    VRD(7); SBAR(); GAPA(C1=__builtin_amdgcn_mfma_f32_32x32x16_bf16(kf[7],qr[3],C1,0,0,0),   P1[14],P1[15],0.f,0.f,       pw3[2]=PKW(P1,12),pw3[3]=PKW(P1,14), pw3); \
    l_reg+=sacc; \
    if(GK){DMA_K((t)+3,sl_cur);} if(GV){DMA_V((t)+1,sl_next);} \
    POST(C0,C1,t); CMASK(C0,C1,t); \
    { float a=MX3(C0[0],C0[1],C1[0]),b=MX3(C0[2],C0[3],C1[1]); a=MX3(a,C1[2],C1[3]); \
      _Pragma("unroll") for(int r=4;r<16;r+=4){a=MX3(a,C0[r],C0[r+1]);b=MX3(b,C0[r+2],C0[r+3]);a=MX3(a,C1[r],C1[r+1]);b=MX3(b,C1[r+2],C1[r+3]);} \
      float rm=__builtin_fmaxf(a,b); { auto rr=__builtin_amdgcn_permlane32_swap(__float_as_uint(rm),__float_as_uint(rm),false,false); rm=__builtin_fmaxf(__uint_as_float(rr[0]),__uint_as_float(rr[1])); } \
      resc=false; \
      if(__builtin_expect(__any(rm>(float)THRL),0)){ const float dl=__builtin_fmaxf(rm,0.f); mhat+=dl; \
        _Pragma("unroll") for(int r=0;r<16;++r){C0[r]-=dl;C1[r]-=dl;} \
        _Pragma("unroll") for(int r=0;r<16;++r)negm[r]=-mhat; asm volatile("":"+v"(negm)); \
        const float f=__builtin_amdgcn_exp2f(-dl); l_reg*=f; if(hi==0)wsf[r32]=f; resc=true; } } \
    SBAR(); \
    GAPB(o[0]=__builtin_amdgcn_mfma_f32_32x32x16_bf16(PAF(0),VFR(0),o[0],0,0,0), C0,0); \
    GAPB(o[1]=__builtin_amdgcn_mfma_f32_32x32x16_bf16(PAF(0),VFR(4),o[1],0,0,0), C0,4); \
    KRD(GL,0); GAPB(o[0]=__builtin_amdgcn_mfma_f32_32x32x16_bf16(PAF(1),VFR(1),o[0],0,0,0), C0,8); \
    KRD(GL,1); GAPB(o[1]=__builtin_amdgcn_mfma_f32_32x32x16_bf16(PAF(1),VFR(5),o[1],0,0,0), C0,12); \
    KRD(GL,2); GAPB(o[0]=__builtin_amdgcn_mfma_f32_32x32x16_bf16(PAF(2),VFR(2),o[0],0,0,0), C1,0); \
    KRD(GL,3); GAPB(o[1]=__builtin_amdgcn_mfma_f32_32x32x16_bf16(PAF(2),VFR(6),o[1],0,0,0), C1,4); \
    GAPB(o[0]=__builtin_amdgcn_mfma_f32_32x32x16_bf16(PAF(3),VFR(3),o[0],0,0,0), C1,8); \
    GAPB(o[1]=__builtin_amdgcn_mfma_f32_32x32x16_bf16(PAF(3),VFR(7),o[1],0,0,0), C1,12); \
    }while(0)
  int t=1;
  #undef CMASK
  #define CMASK(P0,P1,t) do{}while(0)
  for(;t+5<NT;t+=2){
    STEP(pB0,pB1,pA0,pA1,t,true,true,true);     WAIT_BAR(2); RESC(); ROT();
    STEP(pA0,pA1,pB0,pB1,t+1,true,true,true);   WAIT_BAR(2); RESC(); ROT();
  }
  #undef CMASK
  #define CMASK(P0,P1,t) do{int jb_=(t)-(NT-4); if(MODE==0&&jb_>=0)cmask(P0,P1,jb_,qrel,hi);}while(0)
  #define ENDW(tt) do{ if((tt)+3<NT){WAIT_BAR(2);} else if((tt)+2<NT){WAIT_BAR(1);} else {WAIT_BAR(0);} }while(0)
  for(;t+1<NT;t+=2){
    STEP(pB0,pB1,pA0,pA1,t,(t+3<NT),(t+1<NT),(t+1<NT));       ENDW(t);   RESC(); ROT();
    STEP(pA0,pA1,pB0,pB1,t+1,(t+4<NT),(t+2<NT),(t+2<NT));     ENDW(t+1); RESC(); ROT();
  }
  STEP(pB0,pB1,pA0,pA1,NT-1,false,false,false); RESC();
  { float sacc=pB0[0]+pB0[1]; _Pragma("unroll") for(int r=2;r<16;++r)sacc+=pB0[r]; _Pragma("unroll") for(int r=0;r<16;++r)sacc+=pB1[r]; l_reg+=sacc;
    pw0=(u32x4){PKW(pB0,0),PKW(pB0,2),PKW(pB0,4),PKW(pB0,6)};pw1=(u32x4){PKW(pB0,8),PKW(pB0,10),PKW(pB0,12),PKW(pB0,14)};pw2=(u32x4){PKW(pB1,0),PKW(pB1,2),PKW(pB1,4),PKW(pB1,6)};pw3=(u32x4){PKW(pB1,8),PKW(pB1,10),PKW(pB1,12),PKW(pB1,14)};
    SBAR(); pv(o,vb0+sl_cur,PAF(0),PAF(1),PAF(2),PAF(3)); }
  #undef PKW
  #undef PAF
  #undef VFR
  #undef PIN
  #undef MX3
  #undef GAPA
  #undef GAPB
  #undef EX
  #undef VRD
  #undef KRD
  #undef STEP
  #undef ENDW
  {auto rr=__builtin_amdgcn_permlane32_swap(__float_as_uint(l_reg),__float_as_uint(l_reg),false,false);l_reg=__uint_as_float(rr[0])+__uint_as_float(rr[1]);}
  if(hi==0)wsf[32+r32]=l_reg;asm volatile("s_waitcnt lgkmcnt(0)":::"memory");
  float rli[16];
  #pragma unroll
  for(int r=0;r<16;++r)rli[r]=__builtin_amdgcn_rcpf(wsf[32+crow(r,hi)]);
  bf16*Ow=O+(rowbase+q0+wid*QBLK)*DMO+h*D;
  { bf16*stg=(bf16*)(shm+LDS_OST)+wid*2048;
    #pragma unroll
    for(int r=0;r<16;++r){const int orow=crow(r,hi);
      #pragma unroll
      for(int d0=0;d0<2;++d0)stg[orow*64+d0*32+r32]=__float2bfloat16(o[d0][r]*rli[r]);}
    asm volatile("s_waitcnt lgkmcnt(0)":::"memory");
    #pragma unroll
    for(int i=0;i<4;++i){const int row=i*8+(lane>>3),ch=lane&7; const u32x4 v=*(const u32x4*)(stg+row*64+ch*8); ATTN_STORE16(Ow+(long)row*DMO+ch*8,v);
      if(!NOSSQ){float sq=0.f;
      #pragma unroll
      for(int e=0;e<4;++e){const float lo_=__uint_as_float(v[e]<<16),hi_=__uint_as_float(v[e]&0xffff0000u);sq+=lo_*lo_+hi_*hi_;}
      sq+=__shfl_xor(sq,1);sq+=__shfl_xor(sq,2);sq+=__shfl_xor(sq,4);
      if(ch==0)SSQ[(rowbase+q0+wid*QBLK+row)*16+hidx]=sq;}} }
  asm volatile("s_waitcnt lgkmcnt(0)\n\ts_barrier":::"memory");
  #undef DMA_K
  #undef DMA_V
  #undef POST
  #undef CMASK
  #undef START
  #undef RESC
  #undef ROT
}
constexpr int ATTN_LDS_BYTES=LDS_TOTAL;
#undef SBAR
#undef WAIT_BAR
}
constexpr int NWAVES = 8;
constexpr size_t MiB = 1u << 20;
constexpr size_t WS_WIN = 2 * MiB, WS_WOUT = 8 * MiB, WS_WGU = 10 * MiB, WS_WDN = 21 * MiB;
constexpr size_t WS_CBP = 28 * MiB, WS_CBS = 29 * MiB, WS_TAB = 29 * MiB + 512 * 1024, WS_SSQ = 30 * MiB;
constexpr size_t WS_CTL = 0, WS_MIXS = 32 * MiB + 256 * 1024;
constexpr size_t WS_XN = 33 * MiB;
constexpr size_t WS_XN2 = 98 * MiB;
constexpr size_t WS_QKV = 163 * MiB;
constexpr size_t WS_FF = 357 * MiB;
constexpr size_t WS_END = 487 * MiB;
static_assert(WS_XN + (size_t)MPAD * 1024 * 2 <= WS_XN2 && WS_XN2 + (size_t)MPAD * 1024 * 2 <= WS_QKV && WS_QKV + (size_t)MPAD * 3072 * 2 <= WS_FF && WS_FF + (size_t)MPAD * 1024 * 4 <= WS_END, "ws map");
static_assert(WS_SSQ + (size_t)MPAD * 16 * 4 <= WS_XN && WS_WDN + (size_t)1024 * DFF * 2 <= WS_CBP && WS_WGU + (size_t)NGU * 1024 * 2 <= WS_WDN, "ws map 2");
constexpr int RING_BYTES = 131072, TAB_OFF = RING_BYTES  , LDS_BYTES = 147456;

#define LAS __attribute__((address_space(3)))
typedef unsigned short bf16;
typedef unsigned v4u __attribute__((ext_vector_type(4)));
typedef float f32x4 __attribute__((ext_vector_type(4)));
__device__ __forceinline__ unsigned f2bf(float f) { unsigned u = __builtin_bit_cast(unsigned, f); return (u + 0x7fffu + ((u >> 16) & 1u)) >> 16; }
__device__ __forceinline__ unsigned pk2(float lo, float hi) { return f2bf(lo) | (f2bf(hi) << 16); }
__device__ __forceinline__ float bf2f(bf16 b) { return __uint_as_float((unsigned)b << 16); }
__device__ __forceinline__ float wave_sum(float v) {
#pragma unroll
    for (int o = 1; o < 64; o <<= 1) v += __shfl_xor(v, o);
    return v;
}
__device__ __forceinline__ float wave_max(float v) {
#pragma unroll
    for (int o = 1; o < 64; o <<= 1) v = fmaxf(v, __shfl_xor(v, o));
    return v;
}

#ifndef PH
#define PH 255
#endif
#ifndef DUP
#define DUP 0
#endif
#ifndef AM
#define AM 7
#endif
#define XB_TMO      128
#define XB_XCNT(j)  (256  + 64 * (j))
#define XB_XSUB(j)  (1280 + 64 * (j))
#define XB_XGEN(j)  (2304 + 64 * (j))
#define XB_TOP      3328
#define XB_TOPGEN   3392
#define XCD_BAR_WORDS 3456
#define XB_SPIN_CAP (1u << 18)

__device__ __forceinline__ unsigned xb_ld(unsigned* p)              { return __hip_atomic_load(p, __ATOMIC_RELAXED, __HIP_MEMORY_SCOPE_AGENT); }
__device__ __forceinline__ unsigned xb_add(unsigned* p, unsigned v) { return __hip_atomic_fetch_add(p, v, __ATOMIC_RELAXED, __HIP_MEMORY_SCOPE_AGENT); }
__device__ __forceinline__ unsigned xb_xcc_id() { return (unsigned)__builtin_amdgcn_s_getreg((3 << 11) | 20) & 0xFu; }
#define XB_SPIN(cond, bar) do { unsigned _sp = 0; while (cond) { __builtin_amdgcn_s_sleep(1); \
    if ((++_sp & 255u) == 0u) { if (xb_ld(&(bar)[XB_TMO])) break; if (_sp > XB_SPIN_CAP) { atomicAdd(&(bar)[XB_TMO], 1u); break; } } } } while (0)

struct XcdBarrier {
    unsigned* bar; unsigned x;
    volatile LAS unsigned* st;
};

__device__ __forceinline__ XcdBarrier xcd_barrier_post(unsigned* bar, volatile LAS unsigned* st) {
    XcdBarrier b; b.bar = bar; b.x = xb_xcc_id(); b.st = st;
    if (threadIdx.x == 0) (void)xb_add(&bar[XB_XCNT(b.x)], 1u);
    return b;
}
__device__ __forceinline__ void xcd_barrier_complete(unsigned* bar, unsigned x, unsigned& nloc, unsigned& nx) {
    const unsigned G = gridDim.x * gridDim.y * gridDim.z;
    unsigned sum, cnt, mine, sp = 0u;
    for (;;) {
        sum = 0u; cnt = 0u; mine = 0u;
#pragma unroll
        for (unsigned j = 0; j < 16; ++j) { const unsigned c = xb_ld(&bar[XB_XCNT(j)]); sum += c; cnt += (c > 0u) ? 1u : 0u; mine = (j == x) ? c : mine; }
        if (sum == G) break;
        __builtin_amdgcn_s_sleep(1);
        if ((++sp & 255u) == 0u) { if (xb_ld(&bar[XB_TMO])) break; if (sp > XB_SPIN_CAP) { atomicAdd(&bar[XB_TMO], 1u); break; } }
    }
    nloc = mine > 0u ? mine : 1u; nx = cnt > 0u ? cnt : 1u;
}

__device__ __forceinline__ void xcd_barrier(const XcdBarrier& b) {
    asm volatile("s_waitcnt vmcnt(0)" ::: "memory");
    __syncthreads();
    if (threadIdx.x == 0) {
        unsigned* bar = b.bar;
        __builtin_amdgcn_s_waitcnt(0);
        unsigned nloc = b.st[0], nx = b.st[1];
        if (nloc == 0u) { xcd_barrier_complete(bar, b.x, nloc, nx); b.st[0] = nloc; b.st[1] = nx; }
        const unsigned old = xb_add(&bar[XB_XSUB(b.x)], 1u);
        const unsigned gen = old / nloc;
        if (old + 1u == (gen + 1u) * nloc) {
            __builtin_amdgcn_fence(__ATOMIC_RELEASE, "agent");
            asm volatile("s_waitcnt vmcnt(0)" ::: "memory");
            const unsigned og = xb_add(&bar[XB_TOP], 1u);
            const unsigned tg = og / nx;
            if (og + 1u == (tg + 1u) * nx) xb_add(&bar[XB_TOPGEN], 1u);
            else XB_SPIN(xb_ld(&bar[XB_TOPGEN]) == tg, bar);
            __builtin_amdgcn_fence(__ATOMIC_ACQUIRE, "agent");
            xb_add(&bar[XB_XGEN(b.x)], 1u);
            asm volatile("s_waitcnt vmcnt(0)" ::: "memory");
        } else {
            XB_SPIN(xb_ld(&bar[XB_XGEN(b.x)]) == gen, bar);
            __builtin_amdgcn_fence(__ATOMIC_ACQUIRE, "agent");
            asm volatile("s_waitcnt vmcnt(0)" ::: "memory");
        }
    }
    __syncthreads();
}

struct Args { const float* in[20]; float* out; unsigned char* ws; };

__device__ __forceinline__ void p0_transpose_item(const float* src, int ldw, bf16* dst, int Kd, const float* kscale, LAS float* scr, int lane) {
#pragma unroll 8
    for (int i = 0; i < 32; ++i) { const int kk = 2 * i + (lane >> 5); float v = src[(size_t)kk * ldw + (lane & 31)]; if (kscale) v *= kscale[kk]; scr[kk * 33 + (lane & 31)] = v; }
    asm volatile("s_waitcnt lgkmcnt(0)" ::: "memory");
    const int c = lane & 7;
#pragma unroll
    for (int j = 0; j < 4; ++j) { const int n = (lane >> 3) + 8 * j; const LAS float* s = scr + (8 * c) * 33 + n;
        v4u o; o.x = pk2(s[0 * 33], s[1 * 33]); o.y = pk2(s[2 * 33], s[3 * 33]); o.z = pk2(s[4 * 33], s[5 * 33]); o.w = pk2(s[6 * 33], s[7 * 33]);
        *(v4u*)(dst + (size_t)n * Kd + 8 * c) = o; }
    asm volatile("s_waitcnt lgkmcnt(0)" ::: "memory");
}

typedef short bf16x8q __attribute__((ext_vector_type(8)));
__device__ __forceinline__ bf16x8q cvt8(const f32x4 x, const f32x4 y) { v4u r; r.x = pk2(x[0], x[1]); r.y = pk2(x[2], x[3]); r.z = pk2(y[0], y[1]); r.w = pk2(y[2], y[3]); return __builtin_bit_cast(bf16x8q, r); }
__device__ __forceinline__ void sample_attn_item(const Args& a, unsigned char* ws, LAS unsigned char* lds, int item) {
    int tid_ = threadIdx.x; asm volatile("" : "+v"(tid_)); const int tid = tid_, lane = tid & 63, wave = __builtin_amdgcn_readfirstlane(tid >> 6), fr = lane & 15, fq = lane >> 4;
    const int type = item >> 6, s = (item >> 3) & 7, h = item & 7;
    const int ncache = type ? BLEN : PAST, nk = ncache + STOK, ntiles = nk >> 4;
    const float* Kc = (type ? a.in[5] : a.in[2]) + (size_t)s * ncache * 512 + h * 64;
    const float* Vc = (type ? a.in[6] : a.in[3]) + (size_t)s * ncache * 512 + h * 64;
    const float* Kn = a.out + (type ? O_BKS : O_AKS) + (size_t)s * STOK * 512 + h * 64;
    const float* Vn = a.out + (type ? O_BVS : O_AVS) + (size_t)s * STOK * 512 + h * 64;
    const bf16* QKV = (const bf16*)(ws + WS_QKV);
    bf16* O = (bf16*)(ws + WS_XN);
    float* SSQ = (float*)(ws + WS_SSQ);
    const float* cbg = type ? (const float*)(ws + WS_TAB) + h * 2048 : (const float*)(ws + WS_CBS) + (size_t)(s * 8 + h) * 1040;
    constexpr int SCP = 1060;
    LAS float* SC = (LAS float*)lds;
    LAS float* LL = (LAS float*)(lds + 16 * SCP * 4);
    LAS float* OP = (LAS float*)(lds + 16 * SCP * 4 + 256);
    const bf16* qrow = QKV + (size_t)(MP + s * STOK + fr) * NQKV + (type ? 1536 : 0) + h * 64 + 8 * fq;
    const bf16x8q qf0 = *(const bf16x8q*)qrow, qf1 = *(const bf16x8q*)(qrow + 32);
    for (int t0 = wave; t0 < ntiles; t0 += 24) {
        f32x4 kk[3][4];
#pragma unroll
        for (int u = 0; u < 3; ++u) { const int t = t0 + 8 * u, tt = t < ntiles ? t : ntiles - 1, key = 16 * tt + fr;
            const float* kr = (key < ncache ? Kc + (size_t)key * 512 : Kn + (size_t)(key - ncache) * 512) + 8 * fq;
            kk[u][0] = *(const f32x4*)kr; kk[u][1] = *(const f32x4*)(kr + 4); kk[u][2] = *(const f32x4*)(kr + 32); kk[u][3] = *(const f32x4*)(kr + 36); }
        __builtin_amdgcn_sched_barrier(0);
#pragma unroll
        for (int u = 0; u < 3; ++u) { const int t = t0 + 8 * u;
            if (t < ntiles) {
                f32x4 acc = __builtin_amdgcn_mfma_f32_16x16x32_bf16(cvt8(kk[u][0], kk[u][1]), qf0, (f32x4){0.f, 0.f, 0.f, 0.f}, 0, 0, 0);
                acc = __builtin_amdgcn_mfma_f32_16x16x32_bf16(cvt8(kk[u][2], kk[u][3]), qf1, acc, 0, 0, 0);
                const int k0 = 16 * t + 4 * fq;
                if (type == 0) { const f32x4 bb = *(const f32x4*)(cbg + k0); acc = acc + bb;
#pragma unroll
                    for (int e = 0; e < 4; ++e) if (k0 + e > ncache + fr) acc[e] = -INFINITY; }
                else {
#pragma unroll
                    for (int e = 0; e < 4; ++e) { int d = fr + BLEN - (k0 + e); d = d < -128 ? -128 : (d > 128 ? 128 : d); acc[e] += cbg[d + 128]; } }
                *(LAS f32x4*)(SC + fr * SCP + k0) = acc;
            } }
    }
    __syncthreads();
    {
        const int i0 = 2 * wave, i1 = i0 + 1;
        float m0 = -INFINITY, m1 = -INFINITY;
        for (int j = lane; j < nk; j += 64) { m0 = fmaxf(m0, SC[i0 * SCP + j]); m1 = fmaxf(m1, SC[i1 * SCP + j]); }
        m0 = wave_max(m0); m1 = wave_max(m1);
        float l0 = 0.f, l1 = 0.f;
        for (int j = lane; j < nk; j += 64) { const float p0 = __builtin_amdgcn_exp2f(SC[i0 * SCP + j] - m0), p1 = __builtin_amdgcn_exp2f(SC[i1 * SCP + j] - m1); SC[i0 * SCP + j] = p0; SC[i1 * SCP + j] = p1; l0 += p0; l1 += p1; }
        l0 = wave_sum(l0); l1 = wave_sum(l1);
        if (lane == 0) { LL[i0] = l0; LL[i1] = l1; }
    }
    __syncthreads();
    {
        float o[16];
#pragma unroll
        for (int q = 0; q < 16; ++q) o[q] = 0.f;
        for (int t0 = wave; t0 < ntiles; t0 += 16) {
            float vv[2][16];
#pragma unroll
            for (int u = 0; u < 2; ++u) { const int t = t0 + 8 * u, tt = t < ntiles ? t : ntiles - 1;
#pragma unroll
                for (int k = 0; k < 16; ++k) { const int key = 16 * tt + k; vv[u][k] = (key < ncache ? Vc + (size_t)key * 512 : Vn + (size_t)(key - ncache) * 512)[lane]; } }
            __builtin_amdgcn_sched_barrier(0);
#pragma unroll
            for (int u = 0; u < 2; ++u) { const int t = t0 + 8 * u;
                if (t < ntiles) {
#pragma unroll
                    for (int q = 0; q < 16; ++q) {
#pragma unroll
                        for (int g = 0; g < 4; ++g) { const f32x4 p = *(const LAS f32x4*)(SC + q * SCP + 16 * t + 4 * g);
                            o[q] += p[0] * vv[u][4 * g] + p[1] * vv[u][4 * g + 1] + p[2] * vv[u][4 * g + 2] + p[3] * vv[u][4 * g + 3]; } }
                } }
        }
#pragma unroll
        for (int q = 0; q < 16; ++q) OP[(wave * 16 + q) * 64 + lane] = o[q];
    }
    __syncthreads();
#pragma unroll
    for (int r = 0; r < 2; ++r) { const int q = wave + 8 * r; float sum = 0.f;
#pragma unroll
        for (int w = 0; w < 8; ++w) sum += OP[(w * 16 + q) * 64 + lane];
        const float ov = sum / LL[q]; const unsigned b = f2bf(ov); const size_t row = (size_t)(MP + s * STOK + q);
        O[row * 1024 + type * 512 + h * 64 + lane] = (bf16)b;
        const float f = __uint_as_float(b << 16); const float qs = wave_sum(f * f);
        if (lane == 0) SSQ[row * 16 + type * 8 + h] = qs; }
    __syncthreads();
}

__device__ __forceinline__ void rowpass_mix(const float* mixrow, const float* xrow, float* yrow, bf16* xn2row, const f32x4 (&g1)[4], const f32x4 (&g2)[4], int lane) {
    const f32x4* mr = (const f32x4*)mixrow + lane; const f32x4* xr = (const f32x4*)xrow + lane;
    f32x4 v[4], x[4]; float ss = 0.f;
#pragma unroll
    for (int j = 0; j < 4; ++j) { v[j] = mr[64 * j]; x[j] = xr[64 * j]; ss += (v[j][0] * v[j][0] + v[j][1] * v[j][1]) + (v[j][2] * v[j][2] + v[j][3] * v[j][3]); }
    const float rstd = 1.0f / sqrtf(wave_sum(ss) * (1.f / 1024.f) + EPS);
    float s2 = 0.f; f32x4* yr = (f32x4*)yrow + lane;
#pragma unroll
    for (int j = 0; j < 4; ++j) { x[j] = x[j] + v[j] * rstd * g1[j]; yr[64 * j] = x[j]; s2 += (x[j][0] * x[j][0] + x[j][1] * x[j][1]) + (x[j][2] * x[j][2] + x[j][3] * x[j][3]); }
    const float r2 = 1.0f / sqrtf(wave_sum(s2) * (1.f / 1024.f) + EPS);
    unsigned long long* o8 = (unsigned long long*)xn2row + lane;
#pragma unroll
    for (int j = 0; j < 4; ++j) { const f32x4 t = x[j] * r2 * g2[j]; o8[64 * j] = (unsigned long long)pk2(t[0], t[1]) | ((unsigned long long)pk2(t[2], t[3]) << 32); }
}
__device__ __forceinline__ void rowpass_ff(const float* ffrow, float* yrow, const f32x4 (&g3)[4], int lane) {
    const f32x4* fr = (const f32x4*)ffrow + lane; f32x4* yr = (f32x4*)yrow + lane;
    f32x4 v[4], x[4]; float ss = 0.f;
#pragma unroll
    for (int j = 0; j < 4; ++j) { v[j] = fr[64 * j]; x[j] = yr[64 * j]; ss += (v[j][0] * v[j][0] + v[j][1] * v[j][1]) + (v[j][2] * v[j][2] + v[j][3] * v[j][3]); }
    const float rstd = 1.0f / sqrtf(wave_sum(ss) * (1.f / 1024.f) + EPS);
#pragma unroll
    for (int j = 0; j < 4; ++j) yr[64 * j] = x[j] + v[j] * rstd * g3[j];
}

typedef short bf16x8v __attribute__((ext_vector_type(8)));
template <int U> __device__ __forceinline__ void skinny_k(const bf16* Arow, const bf16* B0row, const bf16* B1row, int ksteps, f32x4& acc0, f32x4& acc1) {
    const bf16x8v* ap = (const bf16x8v*)Arow; const bf16x8v* b0p = (const bf16x8v*)B0row; const bf16x8v* b1p = (const bf16x8v*)B1row;
    for (int k0 = 0; k0 < ksteps; k0 += U) {
        bf16x8v av[U], b0[U], b1[U];
#pragma unroll
        for (int u = 0; u < U; ++u) { av[u] = ap[4 * (k0 + u)]; b0[u] = b0p[4 * (k0 + u)]; b1[u] = b1p[4 * (k0 + u)]; }
        __builtin_amdgcn_sched_barrier(0);
#pragma unroll
        for (int u = 0; u < U; ++u) { acc0 = __builtin_amdgcn_mfma_f32_16x16x32_bf16(b0[u], av[u], acc0, 0, 0, 0); acc1 = __builtin_amdgcn_mfma_f32_16x16x32_bf16(b1[u], av[u], acc1, 0, 0, 0); }
    }
}
__device__ __forceinline__ void slab_rendezvous(unsigned* cnt, unsigned total, int tid) {
    __threadfence(); __syncthreads();
    if (tid == 0) { __hip_atomic_fetch_add(cnt, 1u, __ATOMIC_RELAXED, __HIP_MEMORY_SCOPE_AGENT);
        unsigned spins = 0; while (__hip_atomic_load(cnt, __ATOMIC_RELAXED, __HIP_MEMORY_SCOPE_AGENT) < total && ++spins < (1u << 22)) __builtin_amdgcn_s_sleep(2); }
    __syncthreads(); __threadfence();
}
#define SK_TID() int tid_ = threadIdx.x; asm volatile("" : "+v"(tid_)); const int tid = tid_, lane = tid & 63, wave = __builtin_amdgcn_readfirstlane(tid >> 6), fr = lane & 15, fq = lane >> 4, row = 16 * wave + fr; (void)tid
__device__ __forceinline__ void s1_slab(int j, const bf16* XN, const bf16* Win_t, bf16* QKV, float* out) {
    SK_TID();
    f32x4 acc[2] = {(f32x4){0.f, 0.f, 0.f, 0.f}, (f32x4){0.f, 0.f, 0.f, 0.f}};
    skinny_k<16>(XN + (size_t)(MP + row) * 1024 + 8 * fq, Win_t + (size_t)(32 * j + fr) * 1024 + 8 * fq, Win_t + (size_t)(32 * j + 16 + fr) * 1024 + 8 * fq, 32, acc[0], acc[1]);
    const int type = (32 * j) >> 9; const float sc = (type == 0 || type == 3) ? C2 : 1.f;
    float* fb = (type == 1) ? out + O_AKS : (type == 2) ? out + O_AVS : (type == 4) ? out + O_BKS : (type == 5) ? out + O_BVS : nullptr;
#pragma unroll
    for (int f = 0; f < 2; ++f) { const int col = 32 * j + 16 * f + 4 * fq; const f32x4 v = acc[f];
        if (fb) *(f32x4*)(fb + (size_t)row * 512 + (col & 511)) = v;
        *(unsigned long long*)(QKV + (size_t)(MP + row) * NQKV + col) = (unsigned long long)pk2(v[0] * sc, v[1] * sc) | ((unsigned long long)pk2(v[2] * sc, v[3] * sc) << 32); }
}
__device__ __forceinline__ void s3_item(int j, int ks, const bf16* O, const bf16* Wout_t, const float* SSQ, float* MIXS) {
    SK_TID();
    const f32x4* sp = (const f32x4*)(SSQ + (size_t)(MP + row) * 16 + (ks >= 4 ? 8 : 0)); const f32x4 s0 = sp[0], s1 = sp[1];
    const float qq = ((s0[0] + s0[1]) + (s0[2] + s0[3])) + ((s1[0] + s1[1]) + (s1[2] + s1[3]));
    const float rr = 1.0f / sqrtf(qq * (1.f / 512.f) + EPS);
    f32x4 acc[2] = {(f32x4){0.f, 0.f, 0.f, 0.f}, (f32x4){0.f, 0.f, 0.f, 0.f}};
    const bf16* ar = O + (size_t)(MP + row) * 1024 + 128 * ks + 8 * fq; const bf16* b0 = Wout_t + (size_t)(32 * j + fr) * 1024 + 128 * ks + 8 * fq;
    skinny_k<4>(ar, b0, b0 + 16 * 1024, 4, acc[0], acc[1]);
#pragma unroll
    for (int f = 0; f < 2; ++f)
#pragma unroll
        for (int e = 0; e < 4; ++e) __hip_atomic_fetch_add(MIXS + (size_t)row * 1024 + 32 * j + 16 * f + 4 * fq + e, acc[f][e] * rr, __ATOMIC_RELAXED, __HIP_MEMORY_SCOPE_AGENT);
}
__device__ __forceinline__ void s4_slab(int j, const bf16* XN2, const bf16* Wgu_t, bf16* H) {
    SK_TID();
    const int g0 = 256 * ((16 * j) >> 7) + ((16 * j) & 127);
    f32x4 acc[2] = {(f32x4){0.f, 0.f, 0.f, 0.f}, (f32x4){0.f, 0.f, 0.f, 0.f}};
    skinny_k<16>(XN2 + (size_t)(MP + row) * 1024 + 8 * fq, Wgu_t + (size_t)(g0 + fr) * 1024 + 8 * fq, Wgu_t + (size_t)(g0 + 128 + fr) * 1024 + 8 * fq, 32, acc[0], acc[1]);
    float hv[4];
#pragma unroll
    for (int e = 0; e < 4; ++e) { const float g = acc[0][e], up = acc[1][e]; hv[e] = g * up * __builtin_amdgcn_rcpf(1.0f + __builtin_amdgcn_exp2f(-g * LOG2E)); }
    *(unsigned long long*)(H + (size_t)(MP + row) * DFF + 16 * j + 4 * fq) = (unsigned long long)pk2(hv[0], hv[1]) | ((unsigned long long)pk2(hv[2], hv[3]) << 32);
}
__device__ __forceinline__ void s5_item(int j, int ks, const bf16* H, const bf16* Wdn_t, float* FFS) {
    SK_TID();
    f32x4 acc[2] = {(f32x4){0.f, 0.f, 0.f, 0.f}, (f32x4){0.f, 0.f, 0.f, 0.f}};
    const bf16* b0 = Wdn_t + (size_t)(32 * j + fr) * DFF + 352 * ks + 8 * fq;
    skinny_k<11>(H + (size_t)(MP + row) * DFF + 352 * ks + 8 * fq, b0, b0 + 16 * DFF, 11, acc[0], acc[1]);
#pragma unroll
    for (int f = 0; f < 2; ++f)
#pragma unroll
        for (int e = 0; e < 4; ++e) __hip_atomic_fetch_add(FFS + (size_t)row * 1024 + 32 * j + 16 * f + 4 * fq + e, acc[f][e], __ATOMIC_RELAXED, __HIP_MEMORY_SCOPE_AGENT);
}

__global__ void __launch_bounds__(NWAVES * 64, 2) fwd_megakernel(Args a) {
    extern __shared__ __attribute__((aligned(16))) unsigned char lds_raw[];
    cg::grid_group grid = cg::this_grid();
    LAS unsigned char* lds = (LAS unsigned char*)lds_raw;
#define FRESH_TID() int tid_ = threadIdx.x; asm volatile("" : "+v"(tid_)); const int tid = tid_, lane = tid & 63, wave = __builtin_amdgcn_readfirstlane(tid >> 6); const int gw = vcu * NWAVES + wave; (void)lane; (void)gw
    const int G = gridDim.x, bx = blockIdx.x;
    const int vcu = (G % 8 == 0) ? (bx % 8) * (G / 8) + bx / 8 : bx;
    unsigned char* ws = a.ws;
    const float* xp = a.in[0]; const float* xs = a.in[1];
    bf16* Win_t = (bf16*)(ws + WS_WIN); bf16* Wout_t = (bf16*)(ws + WS_WOUT); bf16* Wgu_t = (bf16*)(ws + WS_WGU); bf16* Wdn_t = (bf16*)(ws + WS_WDN);
    bf16* XN = (bf16*)(ws + WS_XN); bf16* XN2 = (bf16*)(ws + WS_XN2); bf16* QKV = (bf16*)(ws + WS_QKV); bf16* HB = (bf16*)(ws + WS_QKV);
    float* MIX = (float*)(ws + WS_QKV); float* FF = (float*)(ws + WS_FF); float* SSQ = (float*)(ws + WS_SSQ);
    float* CBP = (float*)(ws + WS_CBP); float* CBS = (float*)(ws + WS_CBS); float* TAB = (float*)(ws + WS_TAB);
    float* Y = a.out + O_Y; float* MIXS = (float*)(ws + WS_MIXS); unsigned* ctl = (unsigned*)(ws + WS_CTL); LAS unsigned* lflag = (LAS unsigned*)(lds + TAB_OFF + 2048);
    const int NGW = G * NWAVES;
    volatile LAS unsigned* bst = (volatile LAS unsigned*)(lds + TAB_OFF + 4096);
    if (threadIdx.x < 2) bst[threadIdx.x] = 0u;
    __syncthreads();
    const XcdBarrier bar = xcd_barrier_post(ctl + 4096, bst);
    if (gridDim.y == 12345u) grid.sync();

#if PH & 1
    for (int rep_ = 0; rep_ < ((DUP & 1) ? 2 : 1); ++rep_) {
        FRESH_TID();
        LAS float* scr = (LAS float*)(lds + wave * 16384);
        constexpr int I_IN = 16 * 96, I_OUT = 16 * 32, I_G = 16 * 88, I_D = 44 * 32, NITEMS = I_IN + I_OUT + 2 * I_G + I_D;
        for (int it = gw; it < NITEMS; it += NGW) {
            int r = it;
            if (r < I_IN) { const int kb = r / 96, nb = r % 96, n0 = nb * 32, sc0 = n0 < 1536 ? n0 : n0 + 8;
                p0_transpose_item(a.in[8] + (size_t)(kb * 64) * DIN + sc0, DIN, Win_t + (size_t)n0 * 1024 + kb * 64, 1024, nullptr, scr, lane); continue; } r -= I_IN;
            if (r < I_OUT) { const int kb = r / 32, nb = r % 32, k0 = kb * 64; const float* ks = (k0 < 512 ? a.in[11] + k0 : a.in[12] + (k0 - 512));
                p0_transpose_item(a.in[13] + (size_t)k0 * 1024 + nb * 32, 1024, Wout_t + (size_t)(nb * 32) * 1024 + k0, 1024, ks, scr, lane); continue; } r -= I_OUT;
            if (r < 2 * I_G) { const int up = r >= I_G; if (up) r -= I_G; const int kb = r / 88, nb = r % 88, n0 = nb * 32, drow = 256 * (n0 / 128) + (up ? 128 : 0) + (n0 % 128);
                p0_transpose_item((up ? a.in[17] : a.in[16]) + (size_t)(kb * 64) * DFF + n0, DFF, Wgu_t + (size_t)drow * 1024 + kb * 64, 1024, nullptr, scr, lane); continue; } r -= 2 * I_G;
            { const int kb = r / 32, nb = r % 32;
                p0_transpose_item(a.in[18] + (size_t)(kb * 64) * 1024 + nb * 32, 1024, Wdn_t + (size_t)(nb * 32) * DFF + kb * 64, DFF, nullptr, scr, lane); }
        }
        {
            float wf[16][8];
#pragma unroll
            for (int j = 0; j < 4; ++j)
#pragma unroll
                for (int e = 0; e < 4; ++e) { const int k = 256 * j + 4 * lane + e; const f32x4* p = (const f32x4*)(a.in[8] + (size_t)k * DIN + 1536); const f32x4 u0 = p[0], u1 = p[1];
                    wf[4 * j + e][0] = u0[0]; wf[4 * j + e][1] = u0[1]; wf[4 * j + e][2] = u0[2]; wf[4 * j + e][3] = u0[3]; wf[4 * j + e][4] = u1[0]; wf[4 * j + e][5] = u1[1]; wf[4 * j + e][6] = u1[2]; wf[4 * j + e][7] = u1[3]; }
            f32x4 gv[4];
#pragma unroll
            for (int j = 0; j < 4; ++j) gv[j] = ((const f32x4*)a.in[7])[64 * j + lane];
            const float bfv = a.in[9][lane & 7];
            for (int m = gw; m < MTOT; m += NGW) {
                const f32x4* xr = (const f32x4*)(m < MP ? xp + (size_t)m * 1024 : xs + (size_t)(m - MP) * 1024) + lane;
                f32x4 v[4]; float ss = 0.f;
#pragma unroll
                for (int j = 0; j < 4; ++j) { v[j] = xr[64 * j]; ss += (v[j][0] * v[j][0] + v[j][1] * v[j][1]) + (v[j][2] * v[j][2] + v[j][3] * v[j][3]); }
                const float rstd = 1.0f / sqrtf(wave_sum(ss) * (1.f / 1024.f) + EPS);
                float z[8];
#pragma unroll
                for (int c = 0; c < 8; ++c) z[c] = 0.f;
                unsigned long long* o8 = (unsigned long long*)(XN + (size_t)m * 1024) + lane;
#pragma unroll
                for (int j = 0; j < 4; ++j) { v[j] = v[j] * rstd * gv[j];
                    o8[64 * j] = (unsigned long long)pk2(v[j][0], v[j][1]) | ((unsigned long long)pk2(v[j][2], v[j][3]) << 32);
#pragma unroll
                    for (int e = 0; e < 4; ++e)
#pragma unroll
                        for (int c = 0; c < 8; ++c) z[c] += v[j][e] * wf[4 * j + e][c]; }
#pragma unroll
                for (int c = 0; c < 8; ++c) z[c] = wave_sum(z[c]);
                float zz = z[0];
#pragma unroll
                for (int c = 1; c < 8; ++c) zz = (lane == c) ? z[c] : zz;
                if (lane < 8) { const float t = zz + bfv; const float lf = fminf(t, 0.f) - log1pf(expf(-fabsf(t)));
                    if (m < MP) a.out[O_LFP + (size_t)m * 8 + lane] = lf; else a.out[O_LFS + (size_t)(m - MP) * 8 + lane] = lf; }
            }
        }
        for (int i = bx * 512 + tid; i < (MPAD - MTOT) * 1024 * 2 / 16; i += G * 512) ((v4u*)(XN + (size_t)MTOT * 1024))[i] = (v4u){0u, 0u, 0u, 0u};
    }
#endif
    xcd_barrier(bar);

#if PH & 2
    for (int rep_ = 0; rep_ < ((DUP & 2) ? 2 : 1); ++rep_) {
        FRESH_TID();
        if (bx < 192) {
            const bool smp = bx >= 128; const int bb = smp ? (bx - 128) >> 3 : bx >> 3, h = bx & 7; const int n = smp ? PAST + STOK : SEQ;
            float v[4];
#pragma unroll
            for (int e = 0; e < 4; ++e) { const int i = 4 * tid + e; float x = 0.f;
                if (i < n) { if (!smp) x = a.out[O_LFP + ((size_t)bb * SEQ + i) * 8 + h]; else x = i < PAST ? a.in[4][((size_t)bb * PAST + i) * 8 + h] : a.out[O_LFS + ((size_t)bb * STOK + (i - PAST)) * 8 + h]; }
                v[e] = x; }
            v[1] += v[0]; v[2] += v[1]; v[3] += v[2];
            const float tot = v[3]; float sc = tot;
#pragma unroll
            for (int o = 1; o < 64; o <<= 1) { const float t = __shfl_up(sc, o); if (lane >= o) sc += t; }
            LAS float* wt = (LAS float*)lds;
            if (lane == 63) wt[wave] = sc;
            __syncthreads();
            float base = sc - tot;
            for (int w = 0; w < wave; ++w) base += wt[w];
            float* dst = smp ? CBS + (size_t)(bb * 8 + h) * 1040 : CBP + (size_t)(bb * 8 + h) * SEQ;
#pragma unroll
            for (int e = 0; e < 4; ++e) { const int i = 4 * tid + e; if (i < n) dst[i] = -(base + v[e]) * LOG2E; }
        } else if (bx < 224) {
            const int idx = (bx - 192) * 512 + tid, h = idx >> 11, i = idx & 2047; TAB[idx] = i < 256 ? (a.in[10][h * 257 + i] - a.in[10][h * 257 + 256]) * LOG2E : 0.f;
        }
        for (int i = bx * 512 + tid; i < MS * 1024 / 4; i += G * 512) ((f32x4*)MIXS)[i] = (f32x4){0.f, 0.f, 0.f, 0.f};
        __syncthreads();
        pg8::Gemm g{XN, Win_t, MP, NQKV, 1024}; pg8::StaticOrder S; S.init(MP, NQKV, G, bx);
        pg8::EpiQKV E{QKV, a.out};
        pg8::gemm_phase<pg8::EpiQKV, pg8::StaticOrder, true, true>(lds, g, S, E);
        for (int j = G - 1 - bx; j < NQKV / 32; j += G) s1_slab(j, XN, Win_t, QKV, a.out);
    }
#endif
    xcd_barrier(bar);

#if PH & 4
    for (int rep_ = 0; rep_ < ((DUP & 4) ? 2 : 1); ++rep_) {
        FRESH_TID();
        using abf = attn_body::bf16;
        const abf* Qb = (const abf*)QKV; abf* Ob = (abf*)XN;
        for (int v = vcu; v < 256; v += G) {
            const int pr = v >> 1, half = v & 1, b = pr >> 3, h = pr & 7;
            const float* cbg = CBP + (size_t)(b * 8 + h) * SEQ; const float* tbg = TAB + h * 2048;
            const unsigned long long sched = half ? 0x89FE12345ull : 0xDCBA067ull;
            const int nun = half ? 9 : 7;
            for (int i = 0; i < nun; ++i) { const int e = (int)((sched >> (4 * i)) & 15ull), qb = e & 7;
                if (e < 8) {
#if AM & 1
                    attn_body::attn_unit<0, 8>(b, h, qb, Qb, Qb + 512, Qb + 1024, Ob, SSQ, h, cbg, (char*)lds_raw);
#endif
                } else {
#if AM & 2
                    attn_body::attn_unit<1, 8>(b, h, qb, Qb + 1536, Qb + 2048, Qb + 2560, Ob + 512, SSQ, 8 + h, tbg, (char*)lds_raw);
#endif
                }
            }
#if AM & 4
            if (half == 0 && pr < 128) sample_attn_item(a, ws, lds, pr);
#endif
        }
    }
#endif
    xcd_barrier(bar);

#if PH & 8
    for (int rep_ = 0; rep_ < ((DUP & 8) ? 2 : 1); ++rep_) {
        FRESH_TID();
        pg8::Gemm g{XN, Wout_t, MP, 1024, 1024}; pg8::StaticOrder S; S.init(MP, 1024, G, bx);
        LAS float* tab = (LAS float*)(lds + TAB_OFF);
        pg8::Unit u;
        for (int i = 0; S.next(i, u); ++i) {
            if (tid < 256) { const f32x4* sp = (const f32x4*)(SSQ + (size_t)(u.pm * 256 + tid) * 16); const f32x4 s0 = sp[0], s1 = sp[1], s2 = sp[2], s3 = sp[3];
                const float qa = ((s0[0] + s0[1]) + (s0[2] + s0[3])) + ((s1[0] + s1[1]) + (s1[2] + s1[3])), qb = ((s2[0] + s2[1]) + (s2[2] + s2[3])) + ((s3[0] + s3[1]) + (s3[2] + s3[3]));
                const float ra = 1.0f / sqrtf(fabsf(qa) * (1.f / 512.f) + EPS), rb = 1.0f / sqrtf(fabsf(qb) * (1.f / 512.f) + EPS);
                tab[2 * tid] = ra / rb; tab[2 * tid + 1] = rb; }
            __syncthreads();
            pg8::EpiF32<true> E{MIX, 1024, tab};
            pg8::gemm_phase<pg8::EpiF32<true>, pg8::OneUnit, false, true>(lds, g, pg8::OneUnit{u}, E);
            __syncthreads();
        }
        if (rep_ == 0) {
            for (int it = bx; it < 256; it += G) s3_item(it & 31, it >> 5, XN, Wout_t, SSQ, MIXS);
        }
    }
#endif
    xcd_barrier(bar);

#if PH & 16
    for (int rep_ = 0; rep_ < ((DUP & 16) ? 2 : 1); ++rep_) {
        FRESH_TID();
        f32x4 g1[4], g2[4];
#pragma unroll
        for (int j = 0; j < 4; ++j) { g1[j] = ((const f32x4*)a.in[14])[64 * j + lane]; g2[j] = ((const f32x4*)a.in[15])[64 * j + lane]; }
        if (bx < 16) { const int r = 8 * bx + wave; rowpass_mix(MIXS + (size_t)r * 1024, xs + (size_t)r * 1024, Y + (size_t)(MP + r) * 1024, XN2 + (size_t)(MP + r) * 1024, g1, g2, lane); }
        for (int m = gw; m < MP; m += NGW) rowpass_mix(MIX + (size_t)m * 1024, xp + (size_t)m * 1024, Y + (size_t)m * 1024, XN2 + (size_t)m * 1024, g1, g2, lane);
    }
#endif
    xcd_barrier(bar);

#if PH & 32
    for (int rep_ = 0; rep_ < ((DUP & 32) ? 2 : 1); ++rep_) {
        FRESH_TID();
        for (int i = bx * 512 + tid; i < MS * 1024 / 4; i += G * 512) ((f32x4*)MIXS)[i] = (f32x4){0.f, 0.f, 0.f, 0.f};
        pg8::Gemm g{XN2, Wgu_t, MP, NGU, 1024}; pg8::StaticOrder S; S.init(MP, NGU, G, bx);
        pg8::EpiSwiGLU E{HB};
        pg8::gemm_phase<pg8::EpiSwiGLU, pg8::StaticOrder, true, true>(lds, g, S, E);
        for (int j = G - 1 - bx; j < DFF / 16; j += G) s4_slab(j, XN2, Wgu_t, HB);
    }
#endif
    xcd_barrier(bar);

#if PH & 64
    for (int rep_ = 0; rep_ < ((DUP & 64) ? 2 : 1); ++rep_) {
        FRESH_TID();
        pg8::Gemm g{HB, Wdn_t, MP, 1024, DFF}; pg8::StaticOrder S; S.init(MP, 1024, G, bx);
        pg8::EpiF32<false> E{FF, 1024, nullptr};
        pg8::gemm_phase<pg8::EpiF32<false>, pg8::StaticOrder, true, true>(lds, g, S, E);
        if (rep_ == 0) {
            for (int it = bx; it < 256; it += G) s5_item(it & 31, it >> 5, HB, Wdn_t, MIXS);
        }
    }
#endif
    xcd_barrier(bar);

#if PH & 128
    for (int rep_ = 0; rep_ < ((DUP & 128) ? 2 : 1); ++rep_) {
        FRESH_TID();
        f32x4 g3[4];
#pragma unroll
        for (int j = 0; j < 4; ++j) g3[j] = ((const f32x4*)a.in[19])[64 * j + lane];
        if (bx < 16) { const int r = 8 * bx + wave; rowpass_ff(MIXS + (size_t)r * 1024, Y + (size_t)(MP + r) * 1024, g3, lane); }
        for (int m = gw; m < MP; m += NGW) rowpass_ff(FF + (size_t)m * 1024, Y + (size_t)m * 1024, g3, lane);
    }
#endif
}

extern "C" void kernel_launch(void* const* d_in, const int* in_sizes, int n_in, void* d_out, int out_size, void* d_ws, size_t ws_size, hipStream_t stream) {
    static int grid = 0;
    if (grid == 0) {
        if (n_in != 20 || out_size != (int)O_END || ws_size < WS_END) { fprintf(stderr, "kernel_launch: unexpected shapes (n_in %d, out %d, ws %zu)\n", n_in, out_size, ws_size); grid = -1; return; }
        int dev = 0, cus = 0, per_cu = 0;
        hipGetDevice(&dev); hipDeviceGetAttribute(&cus, hipDeviceAttributeMultiprocessorCount, dev);
        hipFuncSetAttribute((const void*)fwd_megakernel, hipFuncAttributeMaxDynamicSharedMemorySize, LDS_BYTES);
        hipOccupancyMaxActiveBlocksPerMultiprocessor(&per_cu, (const void*)fwd_megakernel, NWAVES * 64, LDS_BYTES);
        (void)hipGetLastError();
        if (per_cu < 1) { fprintf(stderr, "kernel_launch: occupancy query says %d blocks/CU\n", per_cu); per_cu = 1; }
        grid = cus;
    }
    if (grid < 0) return;
    if (hipMemsetAsync((char*)d_ws + WS_CTL, 0, 65536, stream) != hipSuccess) { fprintf(stderr, "kernel_launch: memset of the control words failed\n"); return; }
    Args a{};
    for (int i = 0; i < 20; ++i) a.in[i] = (const float*)d_in[i];
    a.out = (float*)d_out; a.ws = (unsigned char*)d_ws;
    void* args[] = {&a};
    hipError_t e = hipLaunchCooperativeKernel((const void*)fwd_megakernel, dim3(grid), dim3(NWAVES * 64), args, LDS_BYTES, stream);
    if (e != hipSuccess) fprintf(stderr, "cooperative launch failed: %s (grid %d)\n", hipGetErrorString(e), grid);
}
```
